# Optimizing an MI355X kernel written in HIP

```python
import math
import jax, jax.numpy as jnp
from jax import lax
import numpy as np

D_MODEL = 1024
BATCH = 2
SEQ = 16384
DEPTH = 2

GRID_W = 64
CTX_LEN = 256
RMS_EPS = 1e-6
SCAN_CHUNK = 128
S5_WIDTH = 512
S5_GROUP = 16
S5_GROUPS = S5_WIDTH // S5_GROUP
S5_STATE = 64
RET_HEADS = 4
RET_HEAD_DIM = 128
RET_WIDTH = RET_HEADS * RET_HEAD_DIM
EVEN_IN = S5_WIDTH + 4 * RET_WIDTH
EVEN_MIX = S5_WIDTH + RET_WIDTH
ROPE_BASE = 10000.0
NA_HEADS = 16
NA_HEAD_DIM = 64
NA_WIDTH = NA_HEADS * NA_HEAD_DIM
NA_WIN_ROWS = 8
NA_WIN_COLS = 16
N_EXPERTS = 32
MOE_TOP_K = 4
MOE_FF = D_MODEL
SWIGLU_LIMIT = 7.0
SWIGLU_ALPHA = 1.702
MOE_BLOCK = 128

kernel_name = "hybrid_s5_retention_natten_moe_block"

F32 = jnp.float32


def rms_norm(x, w):
    xf = x.astype(F32)
    y = xf * lax.rsqrt(jnp.mean(xf * xf, axis=-1, keepdims=True) + RMS_EPS)
    return (y * w.astype(F32)).astype(x.dtype)


def modulate(h, shift, scale):
    return h * (1 + scale) + shift


def rope_1d(x, pos):
    half = x.shape[-1] // 2
    freq = ROPE_BASE ** (-jnp.arange(half, dtype=F32) / half)
    ang = pos[:, None] * freq[None, :]
    cos, sin = jnp.cos(ang), jnp.sin(ang)
    xf = x.astype(F32)
    x1, x2 = xf[..., :half], xf[..., half:]
    return jnp.concatenate([x1 * cos - x2 * sin, x1 * sin + x2 * cos], axis=-1).astype(x.dtype)


def axial_rope_2d(x):
    t = jnp.arange(x.shape[2])
    row = (t // GRID_W).astype(F32)
    col = (t % GRID_W).astype(F32)
    h = x.shape[-1] // 2
    return jnp.concatenate([rope_1d(x[..., :h], row), rope_1d(x[..., h:], col)], axis=-1)


def s5_discretize(lam_re, lam_im, log_step, b_re, b_im):
    lam_re = jnp.minimum(lam_re.astype(F32), -1e-4)
    lam_im = lam_im.astype(F32)
    step = jnp.exp(log_step.astype(F32))[:, None]
    mag = jnp.exp(lam_re * step)
    ang = lam_im * step
    a_re, a_im = mag * jnp.cos(ang), mag * jnp.sin(ang)
    den = lam_re * lam_re + lam_im * lam_im
    n_re, n_im = a_re - 1.0, a_im
    co_re = (n_re * lam_re + n_im * lam_im) / den
    co_im = (n_im * lam_re - n_re * lam_im) / den
    b_re, b_im = b_re.astype(F32), b_im.astype(F32)
    bb_re = co_re[..., None] * b_re - co_im[..., None] * b_im
    bb_im = co_re[..., None] * b_im + co_im[..., None] * b_re
    return a_re, a_im, bb_re, bb_im


def complex_linear_combine(e1, e2):
    a1r, a1i, b1r, b1i = e1
    a2r, a2i, b2r, b2i = e2
    return (a2r * a1r - a2i * a1i, a2r * a1i + a2i * a1r,
            a2r * b1r - a2i * b1i + b2r, a2r * b1i + a2i * b1r + b2i)


def s5_scan(u, a_re, a_im, bb_re, bb_im, c_re, c_im, h_re, h_im):
    bsz, seq_len, g, i = u.shape
    n = seq_len // SCAN_CHUNK
    uc = u.reshape(bsz, n, SCAN_CHUNK, g, i).transpose(1, 0, 2, 3, 4)

    def step(carry, u_blk):
        hr, hi = carry
        bu_re = jnp.einsum('bcgi,gpi->bcgp', u_blk, bb_re)
        bu_im = jnp.einsum('bcgi,gpi->bcgp', u_blk, bb_im)
        bu_re = bu_re.at[:, 0].add(a_re * hr - a_im * hi)
        bu_im = bu_im.at[:, 0].add(a_re * hi + a_im * hr)
        ar = jnp.broadcast_to(a_re, bu_re.shape)
        ai = jnp.broadcast_to(a_im, bu_im.shape)
        _, _, sr, si = lax.associative_scan(complex_linear_combine, (ar, ai, bu_re, bu_im), axis=1)
        y = jnp.einsum('bcgp,gip->bcgi', sr, c_re) - jnp.einsum('bcgp,gip->bcgi', si, c_im)
        return (sr[:, -1], si[:, -1]), y

    (hr, hi), y = lax.scan(step, (h_re, h_im), uc)
    return y.transpose(1, 0, 2, 3, 4).reshape(bsz, seq_len, g, i), hr, hi


def s5_mixer(u_lat, u_ctx, lam_re, lam_im, log_step, b_re, b_im, c_re, c_im, d_skip, w_glu):
    def grouped(u):
        return u.astype(F32).reshape(u.shape[0], u.shape[1], S5_GROUPS, S5_GROUP)
    ul, uc = grouped(u_lat), grouped(u_ctx)
    zeros = jnp.zeros((ul.shape[0], S5_GROUPS, S5_STATE), F32)
    d = d_skip.astype(F32).reshape(S5_GROUPS, S5_GROUP)
    y_lat, y_ctx = ul * d, uc * d
    for dr in range(2):
        a_re, a_im, bb_re, bb_im = s5_discretize(lam_re[dr], lam_im[dr], log_step[dr], b_re[dr], b_im[dr])
        cr, ci = c_re[dr].astype(F32), c_im[dr].astype(F32)
        flip = (lambda t: jnp.flip(t, axis=1)) if dr == 1 else (lambda t: t)
        yc, hr, hi = s5_scan(flip(uc), a_re, a_im, bb_re, bb_im, cr, ci, zeros, zeros)
        yl, _, _ = s5_scan(flip(ul), a_re, a_im, bb_re, bb_im, cr, ci, hr, hi)
        y_ctx = y_ctx + flip(yc)
        y_lat = y_lat + flip(yl)

    def glu(y, like):
        y = jax.nn.gelu(y.reshape(y.shape[0], y.shape[1], S5_WIDTH))
        return (y * jax.nn.sigmoid(y @ w_glu.astype(F32))).astype(like.dtype)
    return glu(y_lat, u_lat), glu(y_ctx, u_ctx)


def retention_scan(q, k, v, log_g, s0):
    bsz, h, seq_len, _ = q.shape
    dv = v.shape[-1]
    c = SCAN_CHUNK
    n = seq_len // c
    idx = jnp.arange(c, dtype=F32)
    diff = idx[:, None] - idx[None, :]
    inner = jnp.where(diff >= 0, jnp.exp(log_g[:, None, None] * jnp.maximum(diff, 0.0)), 0.0)
    q_dec = jnp.exp(log_g[:, None] * (idx + 1.0))[..., None]
    k_dec = jnp.exp(log_g[:, None] * (c - 1.0 - idx))[..., None]
    blk_dec = jnp.exp(log_g * c)[:, None, None]

    def chunks(t):
        return t.reshape(bsz, h, n, c, t.shape[-1]).transpose(2, 0, 1, 3, 4)

    def step(s, blk):
        qb, kb, vb = blk
        att = jnp.einsum('bhid,bhjd->bhij', qb, kb) * inner
        o = jnp.einsum('bhij,bhje->bhie', att, vb) + jnp.einsum('bhid,bhde->bhie', qb, s) * q_dec
        s = blk_dec * s + jnp.einsum('bhjd,bhje->bhde', kb * k_dec, vb)
        return s, o

    s, o = lax.scan(step, s0, (chunks(q), chunks(k), chunks(v)))
    return o.transpose(1, 2, 0, 3, 4).reshape(bsz, h, seq_len, dv), s


def retention_mixer(q_lat, k_lat, v_lat, g_lat, q_ctx, k_ctx, v_ctx, g_ctx, log_decay):
    def heads(t):
        return t.reshape(t.shape[0], t.shape[1], RET_HEADS, RET_HEAD_DIM).transpose(0, 2, 1, 3).astype(F32)
    scale = RET_HEAD_DIM ** -0.5
    ql = axial_rope_2d(heads(q_lat))
    kl = axial_rope_2d(heads(k_lat)) * scale
    qc, kc = heads(q_ctx), heads(k_ctx) * scale
    vl, vc = heads(v_lat), heads(v_ctx)
    s0 = jnp.zeros((ql.shape[0], RET_HEADS, RET_HEAD_DIM, RET_HEAD_DIM), F32)
    o_lat = jnp.zeros_like(vl)
    o_ctx = jnp.zeros_like(vc)
    for dr in range(2):
        lg = log_decay[dr].astype(F32)
        flip = (lambda t: jnp.flip(t, axis=2)) if dr == 1 else (lambda t: t)
        oc, sc = retention_scan(flip(qc), flip(kc), flip(vc), lg, s0)
        ol, _ = retention_scan(flip(ql), flip(kl), flip(vl), lg, sc)
        o_ctx = o_ctx + flip(oc)
        o_lat = o_lat + flip(ol)

    def finish(o, g):
        o = o.transpose(0, 2, 1, 3)
        o = o * lax.rsqrt(jnp.mean(o * o, axis=-1, keepdims=True) + RMS_EPS)
        o = o.reshape(o.shape[0], o.shape[1], RET_WIDTH)
        return (o * jax.nn.silu(g.astype(F32))).astype(g.dtype)
    return finish(o_lat, g_lat), finish(o_ctx, g_ctx)


def even_mixer(h_lat, h_ctx, w_in, w_out, lam_re, lam_im, log_step, b_re, b_im, c_re, c_im, d_skip, w_glu, log_decay):
    def parts(p):
        u = p[..., :S5_WIDTH]
        q, k, v, g = jnp.split(p[..., S5_WIDTH:], 4, axis=-1)
        return u, q, k, v, g
    ul, ql, kl, vl, gl = parts(h_lat @ w_in)
    uc, qc, kc, vc, gc = parts(h_ctx @ w_in)
    a_lat, a_ctx = s5_mixer(ul, uc, lam_re, lam_im, log_step, b_re, b_im, c_re, c_im, d_skip, w_glu)
    r_lat, r_ctx = retention_mixer(ql, kl, vl, gl, qc, kc, vc, gc, log_decay)
    o_lat = jnp.concatenate([a_lat, r_lat], axis=-1) @ w_out
    o_ctx = jnp.concatenate([a_ctx, r_ctx], axis=-1) @ w_out
    return o_lat, o_ctx


def na_mixer(h_lat, h_ctx, w_qkv, w_o, rpb, need_ctx_out):
    bsz, seq_len, _ = h_lat.shape
    rows = seq_len // GRID_W
    kr, kc = min(NA_WIN_ROWS, rows), NA_WIN_COLS
    scale = NA_HEAD_DIM ** -0.5
    qkv = (h_lat @ w_qkv).reshape(bsz, rows, GRID_W, 3, NA_HEADS, NA_HEAD_DIM)
    qg = qkv[:, :, :, 0].transpose(0, 3, 1, 2, 4) * scale
    kg = qkv[:, :, :, 1].transpose(0, 3, 1, 2, 4)
    vg = qkv[:, :, :, 2].transpose(0, 3, 1, 2, 4)
    n_ctx = h_ctx.shape[1]
    cqkv = (h_ctx @ w_qkv).reshape(bsz, n_ctx, 3, NA_HEADS, NA_HEAD_DIM)
    q_ctx = cqkv[:, :, 0].transpose(0, 2, 1, 3) * scale
    k_ctx = cqkv[:, :, 1].transpose(0, 2, 1, 3)
    v_ctx = cqkv[:, :, 2].transpose(0, 2, 1, 3)

    col = jnp.arange(GRID_W)
    col_start = jnp.clip(col - kc // 2, 0, GRID_W - kc)
    col_idx = col_start[:, None] + jnp.arange(kc)[None, :]
    col_off = col_idx - col[:, None] + (NA_WIN_COLS - 1)

    def row_block(r):
        rs = jnp.clip(r - kr // 2, 0, rows - kr)
        q_r = lax.dynamic_index_in_dim(qg, r, axis=2, keepdims=False)
        k_band = lax.dynamic_slice_in_dim(kg, rs, kr, axis=2)
        v_band = lax.dynamic_slice_in_dim(vg, rs, kr, axis=2)
        k_win = k_band[:, :, :, col_idx]
        v_win = v_band[:, :, :, col_idx]
        row_off = rs + jnp.arange(kr) - r + (NA_WIN_ROWS - 1)
        bias = rpb[:, row_off[None, :, None], col_off[:, None, :]]
        s_loc = jnp.einsum('bhqd,bhrqcd->bhqrc', q_r, k_win).astype(F32) + bias.astype(F32)
        s_ctx = jnp.einsum('bhqd,bhkd->bhqk', q_r, k_ctx).astype(F32)
        s = jnp.concatenate([s_loc.reshape(bsz, NA_HEADS, GRID_W, kr * kc), s_ctx], axis=-1)
        p = jax.nn.softmax(s, axis=-1).astype(v_win.dtype)
        p_loc = p[..., :kr * kc].reshape(bsz, NA_HEADS, GRID_W, kr, kc)
        p_ctx = p[..., kr * kc:]
        return (jnp.einsum('bhqrc,bhrqcd->bhqd', p_loc, v_win)
                + jnp.einsum('bhqk,bhkd->bhqd', p_ctx, v_ctx))

    o = lax.map(row_block, jnp.arange(rows))
    o_lat = o.transpose(1, 0, 3, 2, 4).reshape(bsz, seq_len, NA_WIDTH) @ w_o
    if not need_ctx_out:
        return o_lat, None
    s = jnp.einsum('bhqd,bhkd->bhqk', q_ctx, k_ctx).astype(F32)
    p = jax.nn.softmax(s, axis=-1).astype(v_ctx.dtype)
    o_ctx = jnp.einsum('bhqk,bhkd->bhqd', p, v_ctx).transpose(0, 2, 1, 3).reshape(bsz, n_ctx, NA_WIDTH) @ w_o
    return o_lat, o_ctx


def moe_ffn(h, w_router, b_router, w1, b1, w2, b2):
    n_tok, d = h.shape
    logits = (h @ w_router + b_router).astype(F32)
    top_val, top_idx = lax.top_k(logits, MOE_TOP_K)
    gates = jax.nn.softmax(top_val, axis=-1)
    n_assign = n_tok * MOE_TOP_K
    flat_e = top_idx.reshape(-1)
    order = jnp.argsort(flat_e)
    sorted_e = flat_e[order]
    counts = jnp.bincount(flat_e, length=N_EXPERTS)
    starts = jnp.cumsum(counts) - counts
    padded = (counts + MOE_BLOCK - 1) // MOE_BLOCK * MOE_BLOCK
    padded_ends = jnp.cumsum(padded)
    padded_starts = padded_ends - padded
    dest = padded_starts[sorted_e] + jnp.arange(n_assign) - starts[sorted_e]
    n_blocks = -(-n_assign // MOE_BLOCK) + N_EXPERTS
    n_slots = n_blocks * MOE_BLOCK
    slot_tok = jnp.full((n_slots,), n_tok, jnp.int32).at[dest].set((order // MOE_TOP_K).astype(jnp.int32))
    slot_gate = jnp.zeros((n_slots,), F32).at[dest].set(gates.reshape(-1)[order])
    block_e = jnp.minimum(jnp.searchsorted(padded_ends, jnp.arange(n_blocks) * MOE_BLOCK, side='right'),
                          N_EXPERTS - 1)
    h_pad = jnp.concatenate([h, jnp.zeros((1, d), h.dtype)], axis=0)

    def run_block(args):
        tok, e = args
        xb = h_pad[tok]
        t = xb @ w1[e] + b1[e]
        x_glu = jnp.minimum(t[:, :MOE_FF], SWIGLU_LIMIT)
        x_lin = jnp.clip(t[:, MOE_FF:], -SWIGLU_LIMIT, SWIGLU_LIMIT)
        act = x_glu * jax.nn.sigmoid(SWIGLU_ALPHA * x_glu) * (x_lin + 1)
        return act @ w2[e] + b2[e]

    y = lax.map(run_block, (slot_tok.reshape(n_blocks, MOE_BLOCK), block_e))
    y = y.reshape(n_slots, d) * slot_gate[:, None].astype(y.dtype)
    out = jnp.zeros((n_tok + 1, d), y.dtype).at[slot_tok].add(y)
    return out[:n_tok]


def setup_inputs(seed: int = 0) -> dict:
    key = jax.random.key(seed)
    ks = jax.random.split(key, 32)
    n_even = (DEPTH + 1) // 2
    n_odd = DEPTH // 2
    nrm = jax.random.normal
    d = D_MODEL
    lam_im0 = math.pi * jnp.arange(S5_STATE, dtype=F32)
    decay0 = jnp.asarray(np.log(1.0 - 2.0 ** (-5.0 - np.arange(RET_HEADS))), F32)
    return {
        'x': nrm(ks[0], (BATCH, SEQ, d), F32),
        'c': nrm(ks[1], (BATCH, d), F32),
        'ctx': nrm(ks[2], (BATCH, CTX_LEN, d), F32),
        'c_ctx': nrm(ks[3], (d,), F32),
        'ada_w': nrm(ks[4], (DEPTH, d, 6 * d), F32) * (0.5 * d ** -0.5),
        'ada_b': 0.02 * nrm(ks[5], (DEPTH, 6 * d), F32),
        'norm_w': 1.0 + 0.02 * nrm(ks[6], (DEPTH, 2, d), F32),
        'final_norm_w': 1.0 + 0.02 * nrm(ks[7], (d,), F32),
        'ev_w_in': nrm(ks[8], (n_even, d, EVEN_IN), F32) * d ** -0.5,
        'ev_w_out': nrm(ks[9], (n_even, EVEN_MIX, d), F32) * EVEN_MIX ** -0.5,
        's5_lam_re': -0.5 + 0.01 * nrm(ks[10], (n_even, 2, S5_GROUPS, S5_STATE), F32),
        's5_lam_im': lam_im0 + 0.01 * nrm(ks[11], (n_even, 2, S5_GROUPS, S5_STATE), F32),
        's5_log_step': jax.random.uniform(ks[12], (n_even, 2, S5_GROUPS), F32, math.log(1e-3), math.log(1e-1)),
        's5_b_re': nrm(ks[13], (n_even, 2, S5_GROUPS, S5_STATE, S5_GROUP), F32) * (2 * S5_GROUP) ** -0.5,
        's5_b_im': nrm(ks[14], (n_even, 2, S5_GROUPS, S5_STATE, S5_GROUP), F32) * (2 * S5_GROUP) ** -0.5,
        's5_c_re': nrm(ks[15], (n_even, 2, S5_GROUPS, S5_GROUP, S5_STATE), F32) * (2 * S5_STATE) ** -0.5,
        's5_c_im': nrm(ks[16], (n_even, 2, S5_GROUPS, S5_GROUP, S5_STATE), F32) * (2 * S5_STATE) ** -0.5,
        's5_d': nrm(ks[17], (n_even, S5_WIDTH), F32),
        's5_w_glu': nrm(ks[18], (n_even, S5_WIDTH, S5_WIDTH), F32) * S5_WIDTH ** -0.5,
        'ret_log_decay': decay0 * (1.0 + 0.01 * nrm(ks[19], (n_even, 2, RET_HEADS), F32)),
        'na_w_qkv': nrm(ks[20], (n_odd, d, 3 * NA_WIDTH), F32) * d ** -0.5,
        'na_w_o': nrm(ks[21], (n_odd, NA_WIDTH, d), F32) * NA_WIDTH ** -0.5,
        'na_rpb': 0.02 * nrm(ks[22], (n_odd, NA_HEADS, 2 * NA_WIN_ROWS - 1, 2 * NA_WIN_COLS - 1), F32),
        'moe_w_router': nrm(ks[23], (DEPTH, d, N_EXPERTS), F32) * d ** -0.5,
        'moe_b_router': 0.01 * nrm(ks[24], (DEPTH, N_EXPERTS), F32),
        'moe_w1': nrm(ks[25], (DEPTH, N_EXPERTS, d, 2 * MOE_FF), F32) * d ** -0.5,
        'moe_b1': 0.01 * nrm(ks[26], (DEPTH, N_EXPERTS, 2 * MOE_FF), F32),
        'moe_w2': nrm(ks[27], (DEPTH, N_EXPERTS, MOE_FF, d), F32) * MOE_FF ** -0.5,
        'moe_b2': 0.01 * nrm(ks[28], (DEPTH, N_EXPERTS, d), F32),
    }


def reference(x, c, ctx, c_ctx, ada_w, ada_b, norm_w, final_norm_w, ev_w_in, ev_w_out,
              s5_lam_re, s5_lam_im, s5_log_step, s5_b_re, s5_b_im, s5_c_re, s5_c_im, s5_d, s5_w_glu,
              ret_log_decay, na_w_qkv, na_w_o, na_rpb,
              moe_w_router, moe_b_router, moe_w1, moe_b1, moe_w2, moe_b2):
    bsz, seq_len, d = x.shape
    cond_lat = jax.nn.silu(c)
    cond_ctx = jax.nn.silu(c_ctx)
    for i in range(DEPTH):
        last = i == DEPTH - 1
        sh1, sc1, g1, sh2, sc2, g2 = jnp.split(cond_lat @ ada_w[i] + ada_b[i], 6, axis=-1)
        csh1, csc1, cg1, csh2, csc2, cg2 = jnp.split(cond_ctx @ ada_w[i] + ada_b[i], 6, axis=-1)
        h_lat = modulate(rms_norm(x, norm_w[i, 0]), sh1[:, None], sc1[:, None])
        h_ctx = modulate(rms_norm(ctx, norm_w[i, 0]), csh1, csc1)
        if i % 2 == 0:
            j = i // 2
            m_lat, m_ctx = even_mixer(h_lat, h_ctx, ev_w_in[j], ev_w_out[j],
                                      s5_lam_re[j], s5_lam_im[j], s5_log_step[j], s5_b_re[j], s5_b_im[j],
                                      s5_c_re[j], s5_c_im[j], s5_d[j], s5_w_glu[j], ret_log_decay[j])
        else:
            j = i // 2
            m_lat, m_ctx = na_mixer(h_lat, h_ctx, na_w_qkv[j], na_w_o[j], na_rpb[j], not last)
        x = x + g1[:, None] * m_lat
        h_lat = modulate(rms_norm(x, norm_w[i, 1]), sh2[:, None], sc2[:, None])
        if last:
            y = moe_ffn(h_lat.reshape(-1, d), moe_w_router[i], moe_b_router[i],
                        moe_w1[i], moe_b1[i], moe_w2[i], moe_b2[i])
            x = x + g2[:, None] * y.reshape(bsz, seq_len, d)
        else:
            ctx = ctx + cg1 * m_ctx
            h_ctx = modulate(rms_norm(ctx, norm_w[i, 1]), csh2, csc2)
            tokens = jnp.concatenate([h_lat.reshape(-1, d), h_ctx.reshape(-1, d)], axis=0)
            y = moe_ffn(tokens, moe_w_router[i], moe_b_router[i],
                        moe_w1[i], moe_b1[i], moe_w2[i], moe_b2[i])
            n_lat = bsz * seq_len
            x = x + g2[:, None] * y[:n_lat].reshape(bsz, seq_len, d)
            ctx = ctx + cg2 * y[n_lat:].reshape(ctx.shape)
    return rms_norm(x, final_norm_w)
```

```cpp
#include <hip/hip_runtime.h>
#include <cstdio>
#include <cstdint>

#define DI __device__ __forceinline__
#define LAS __attribute__((address_space(3)))
#define GAS __attribute__((address_space(1)))
typedef unsigned short bf16_t;
typedef short bf16x8 __attribute__((ext_vector_type(8)));
typedef short s16x4 __attribute__((ext_vector_type(4)));
typedef float f32x4 __attribute__((ext_vector_type(4)));
typedef float f32x2 __attribute__((ext_vector_type(2)));
typedef float f32x16 __attribute__((ext_vector_type(16)));
typedef unsigned u32x4 __attribute__((ext_vector_type(4)));
typedef unsigned u32x2 __attribute__((ext_vector_type(2)));

constexpr int DM = 1024, NLAT = 32768, NCTX = 512, NROW = NLAT + NCTX, SEQ = 16384, CTXL = 256;
constexpr int NTHR = 512, NWAVE = 8;
constexpr int LDS_BYTES = 156 * 1024;
constexpr int LDS_CTL_OFF = LDS_BYTES - 256;
constexpr int MAXSLOT = 4 * NROW + 32 * 256;
constexpr int MAXTILE = MAXSLOT / 256;

enum { I_X = 0, I_C, I_CTX, I_CCTX, I_ADAW, I_ADAB, I_NORMW, I_FNW, I_WIN, I_WOUT, I_LRE, I_LIM, I_LSTEP, I_BRE, I_BIM, I_CRE, I_CIM, I_S5D, I_WGLU,
       I_DECAY, I_WQKV, I_WO, I_RPB, I_WR, I_BR, I_W1, I_B1, I_W2, I_B2, N_IN };

constexpr size_t MiB = 1u << 20;
constexpr size_t al(size_t x) { return (x + 4095) & ~(size_t)4095; }
constexpr size_t WS_CTL = 0, CTL_BYTES = 1 * MiB;
constexpr size_t WS_MODP = WS_CTL + CTL_BYTES;
constexpr size_t WS_MODF = WS_MODP + al(8 * 2 * 3 * 6144 * 4);
constexpr size_t WS_ROPE = WS_MODF + al(2 * 3 * 6144 * 4);
constexpr size_t WS_S5A = WS_ROPE + al(256 * 32 * 8);
constexpr size_t WS_S5BF = WS_S5A + al(2 * 32 * 64 * 16);
constexpr size_t WS_S5CF = WS_S5BF + al(2 * 32 * 4 * 64 * 16);
constexpr size_t WS_S5E = WS_S5CF + al(2 * 32 * 4 * 64 * 16);
constexpr size_t WS_S5H = WS_S5E + al((size_t)2 * 2 * 32 * 130 * 64 * 8);
constexpr size_t WS_WRT = WS_S5H + al((size_t)2 * 2 * 32 * 130 * 64 * 8);
constexpr size_t WS_WIN = WS_WRT + al(2 * 32 * 1024 * 4);
constexpr size_t WS_WOUT = WS_WIN + al((size_t)2560 * 1024 * 2);
constexpr size_t WS_WGLU = WS_WOUT + al((size_t)1024 * 1024 * 2);
constexpr size_t WS_WQKV = WS_WGLU + al((size_t)512 * 512 * 2);
constexpr size_t WS_WO = WS_WQKV + al((size_t)3072 * 1024 * 2);
constexpr size_t WS_W1 = WS_WO + al((size_t)1024 * 1024 * 2);
constexpr size_t WS_W2 = WS_W1 + al((size_t)2 * 32 * 2048 * 1024 * 2);
constexpr size_t WS_XS = WS_W2 + al((size_t)2 * 32 * 1024 * 1024 * 2);
constexpr size_t WS_H = WS_XS + al((size_t)NROW * 1024 * 4);
constexpr size_t WS_P = WS_H + al((size_t)NROW * 1024 * 2);
constexpr size_t WS_AR = WS_P + al((size_t)NROW * 3072 * 2);
constexpr size_t WS_YG = WS_AR + al((size_t)NROW * 1024 * 2);
constexpr size_t WS_KVL = WS_YG + al((size_t)NROW * 512 * 2);
constexpr size_t WS_SIN = WS_KVL + al((size_t)2 * 4 * 2 * 130 * 16384 * 4);
constexpr size_t WS_ACT = WS_SIN + al((size_t)2 * 4 * 2 * 130 * 16384 * 2);
constexpr size_t WS_Y2 = WS_ACT + al((size_t)MAXSLOT * 1024 * 2);
constexpr size_t WS_SEL = WS_Y2 + al((size_t)MAXSLOT * 1024 * 2);
constexpr size_t WS_GATE = WS_SEL + al((size_t)NROW * 16);
constexpr size_t WS_RSLOT = WS_GATE + al((size_t)NROW * 16);
constexpr size_t WS_STOK = WS_RSLOT + al((size_t)NROW * 16);
constexpr size_t WS_CNT = WS_STOK + al((size_t)MAXSLOT * 4);
constexpr size_t WS_ETOT = WS_CNT + al(256 * 32 * 4);
constexpr size_t WS_END = WS_ETOT + 4096;

DI unsigned f2bf(float f) { unsigned u = __builtin_bit_cast(unsigned, f); return (u + 0x7fffu + ((u >> 16) & 1u)) >> 16; }
typedef __bf16 hbf16x2 __attribute__((ext_vector_type(2)));
DI unsigned pk2(float lo, float hi) { f32x2 v = {lo, hi}; hbf16x2 b = __builtin_convertvector(v, hbf16x2); return __builtin_bit_cast(unsigned, b); }
DI unsigned pk4_fp8(float a, float b, float c, float d) { int w = 0; w = __builtin_amdgcn_cvt_pk_fp8_f32(a, b, w, false); w = __builtin_amdgcn_cvt_pk_fp8_f32(c, d, w, true); return (unsigned)w; }
DI float bflo(unsigned w) { return __builtin_bit_cast(float, w << 16); }
DI float bfhi(unsigned w) { return __builtin_bit_cast(float, w & 0xffff0000u); }
DI float bf1(bf16_t b) { return __builtin_bit_cast(float, (unsigned)b << 16); }
DI void st_i(int* p, int v) { __hip_atomic_store(p, v, __ATOMIC_RELAXED, __HIP_MEMORY_SCOPE_AGENT); }
DI void st_f(float* p, float v) { __hip_atomic_store(p, v, __ATOMIC_RELAXED, __HIP_MEMORY_SCOPE_AGENT); }
DI int ld_i(const int* p) { return __hip_atomic_load(p, __ATOMIC_RELAXED, __HIP_MEMORY_SCOPE_AGENT); }
DI float ld_f(const float* p) { return __hip_atomic_load(p, __ATOMIC_RELAXED, __HIP_MEMORY_SCOPE_AGENT); }
DI int crow(int reg, int h) { return (reg & 3) + 8 * (reg >> 2) + 4 * h; }
DI float sigmoidf_(float x) { return __builtin_amdgcn_rcpf(1.0f + __expf(-x)); }
DI float ex2(float x) { return __builtin_amdgcn_exp2f(x); }
#define MFMA32(a, b, c) __builtin_amdgcn_mfma_f32_32x32x16_bf16((a), (b), (c), 0, 0, 0)
#define MFMA16(a, b, c) __builtin_amdgcn_mfma_f32_16x16x32_bf16((a), (b), (c), 0, 0, 0)
#define LDS_WAIT() asm volatile("s_waitcnt lgkmcnt(0)" ::: "memory")
#define VM_WAIT() asm volatile("s_waitcnt vmcnt(0)" ::: "memory")
DI bf16x8 tr_read2(unsigned a_lo, unsigned a_hi) {
    s16x4 lo, hi;
    asm volatile("ds_read_b64_tr_b16 %0, %2\n\tds_read_b64_tr_b16 %1, %3\n\ts_waitcnt lgkmcnt(0)" : "=&v"(lo), "=&v"(hi) : "v"(a_lo), "v"(a_hi) : "memory");
    return __builtin_shufflevector(lo, hi, 0, 1, 2, 3, 4, 5, 6, 7);
}
DI bf16x8 pack8(const f32x16& x, int s) {
    u32x4 p; p[0] = pk2(x[8 * s], x[8 * s + 1]); p[1] = pk2(x[8 * s + 2], x[8 * s + 3]); p[2] = pk2(x[8 * s + 4], x[8 * s + 5]); p[3] = pk2(x[8 * s + 6], x[8 * s + 7]);
    return __builtin_bit_cast(bf16x8, p);
}
DI f32x16 zero16() { f32x16 z; for (int i = 0; i < 16; ++i) z[i] = 0.f; return z; }

#define XB_TMO      128
#define XB_XCNT(j)  (256  + 64 * (j))
#define XB_FLX(x)   (4096 + 256 * (x))
#define XB_TOPF     16384
#define XB_SPIN_CAP (1u << 22)
DI unsigned xb_ld(unsigned* p)              { return __hip_atomic_load(p, __ATOMIC_RELAXED, __HIP_MEMORY_SCOPE_AGENT); }
DI void xb_st(unsigned* p, unsigned v)      { __hip_atomic_store(p, v, __ATOMIC_RELAXED, __HIP_MEMORY_SCOPE_AGENT); }
DI unsigned xb_add(unsigned* p, unsigned v) { return __hip_atomic_fetch_add(p, v, __ATOMIC_RELAXED, __HIP_MEMORY_SCOPE_AGENT); }
DI unsigned xb_xcc_id() { return (unsigned)__builtin_amdgcn_s_getreg((3 << 11) | 20) & 0xFu; }
struct XcdBarrier { unsigned* bar; unsigned x; volatile LAS unsigned* st; };
DI XcdBarrier xcd_barrier_post(unsigned* bar, volatile LAS unsigned* st) {
    XcdBarrier b; b.bar = bar; b.x = xb_xcc_id(); b.st = st;
    if (threadIdx.x == 0) st[3] = xb_add(&bar[XB_XCNT(b.x)], 1u);
    return b;
}
DI void xcd_barrier_complete(unsigned* bar, unsigned x, unsigned& nloc, unsigned& xmask) {
    const unsigned G = gridDim.x * gridDim.y * gridDim.z;
    unsigned sum, msk, mine, sp = 0u;
    for (;;) {
        sum = 0u; msk = 0u; mine = 0u;
#pragma unroll
        for (unsigned j = 0; j < 16; ++j) { const unsigned c = xb_ld(&bar[XB_XCNT(j)]); sum += c; msk |= (c > 0u) ? (1u << j) : 0u; mine = (j == x) ? c : mine; }
        if (sum == G) break;
        __builtin_amdgcn_s_sleep(1);
        if ((++sp & 255u) == 0u) { if (xb_ld(&bar[XB_TMO])) break; if (sp > XB_SPIN_CAP) { atomicAdd(&bar[XB_TMO], 1u); break; } }
    }
    nloc = mine > 0u ? mine : 1u; xmask = msk ? msk : 1u;
}
DI void xcd_barrier(const XcdBarrier& b) {
    asm volatile("s_waitcnt vmcnt(0)" ::: "memory");
    __syncthreads();
    if (threadIdx.x < 64) {
        const unsigned lane = threadIdx.x; unsigned* bar = b.bar;
        __builtin_amdgcn_s_waitcnt(0);
        unsigned nloc = b.st[0], xmask = b.st[1];
        const unsigned kk = b.st[2] + 1u, rank = b.st[3];
        if (nloc == 0u) { xcd_barrier_complete(bar, b.x, nloc, xmask); if (lane == 0u) { b.st[0] = nloc; b.st[1] = xmask; } }
        if (lane == 0u) xb_st(&bar[XB_FLX(b.x) + rank], kk);
        if (rank == 0u) {
            unsigned sp = 0u;
            for (;;) {
                bool ok = true;
                for (unsigned base = 0u; base < nloc; base += 64u) { const unsigned j = base + lane; const unsigned v = j < nloc ? xb_ld(&bar[XB_FLX(b.x) + j]) : kk; ok = ok && ((int)(v - kk) >= 0); }
                if (__all(ok)) break;
                __builtin_amdgcn_s_sleep(1);
                if ((++sp & 255u) == 0u) { if (xb_ld(&bar[XB_TMO])) break; if (sp > XB_SPIN_CAP) { if (lane == 0u) atomicAdd(&bar[XB_TMO], 1u); break; } }
            }
            if (lane == 0u) {
                __builtin_amdgcn_fence(__ATOMIC_RELEASE, "agent");
                asm volatile("s_waitcnt vmcnt(0)\n\tbuffer_inv sc1\n\ts_waitcnt vmcnt(0)" ::: "memory");
                xb_st(&bar[XB_TOPF + b.x], kk);
            }
        } else if (lane == 0u) {
            asm volatile("buffer_inv sc0" ::: "memory");
        }
        {
            unsigned sp = 0u;
            for (;;) {
                const unsigned v = (lane < 16u && ((xmask >> lane) & 1u)) ? xb_ld(&bar[XB_TOPF + lane]) : kk;
                if (__all((int)(v - kk) >= 0)) break;
                __builtin_amdgcn_s_sleep(1);
                if ((++sp & 255u) == 0u) { if (xb_ld(&bar[XB_TMO])) break; if (sp > XB_SPIN_CAP) { if (lane == 0u) atomicAdd(&bar[XB_TMO], 1u); break; } }
            }
        }
        asm volatile("s_waitcnt vmcnt(0)" ::: "memory");
        if (lane == 0u) b.st[2] = kk;
    }
    __syncthreads();
}

struct Args { const float* in[N_IN]; float* out; unsigned char* ws; int ph_lo, ph_hi; };

DI int chunk_row0(int b, int mc) { return mc < 128 ? b * SEQ + mc * 128 : NLAT + b * CTXL + (mc - 128) * 128; }
DI int row_s(int row) { return row < SEQ ? 0 : (row < NLAT ? 1 : 2); }

DI void transpose_item(const float* W, int K, int N, bf16_t* WT, int nout0, LAS float* scr, int k0, int n0, int lane) {
    float tmp[32];
    const float* wp = W + (size_t)(k0 + (lane >> 5)) * N + n0 + (lane & 31);
#pragma unroll
    for (int i = 0; i < 32; ++i) tmp[i] = wp[(size_t)(2 * i) * N];
#pragma unroll
    for (int i = 0; i < 32; ++i) { const int kk = 2 * i + (lane >> 5); scr[kk * 33 + (lane & 31)] = tmp[i]; }
    LDS_WAIT();
    const int c = lane & 7;
#pragma unroll
    for (int j = 0; j < 4; ++j) { const int n = (lane >> 3) + 8 * j; const LAS float* s = scr + (8 * c) * 33 + n;
        u32x4 o; o[0] = pk2(s[0 * 33], s[1 * 33]); o[1] = pk2(s[2 * 33], s[3 * 33]); o[2] = pk2(s[4 * 33], s[5 * 33]); o[3] = pk2(s[6 * 33], s[7 * 33]);
        *(u32x4*)(WT + (size_t)(nout0 + n) * K + k0 + 8 * c) = o; }
    LDS_WAIT();
}

DI void transpose_item_fp8(const float* W, int K, int N, unsigned char* WT, int nout0, LAS float* scr, int k0, int n0, int lane, float wscale) {
    float tmp[64];
    const float* wp = W + (size_t)(k0 + (lane >> 5)) * N + n0 + (lane & 31);
#pragma unroll
    for (int i = 0; i < 64; ++i) tmp[i] = wp[(size_t)(2 * i) * N];
#pragma unroll
    for (int i = 0; i < 64; ++i) { const int kk = 2 * i + (lane >> 5); scr[kk * 33 + (lane & 31)] = tmp[i] * wscale; }
    LDS_WAIT();
    const int c = lane & 15;
#pragma unroll
    for (int j = 0; j < 8; ++j) { const int n = (lane >> 4) + 4 * j; const LAS float* s = scr + (8 * c) * 33 + n;
        u32x2 o; o[0] = pk4_fp8(s[0 * 33], s[1 * 33], s[2 * 33], s[3 * 33]); o[1] = pk4_fp8(s[4 * 33], s[5 * 33], s[6 * 33], s[7 * 33]);
        *(u32x2*)(WT + (size_t)(nout0 + n) * K + k0 + 8 * c) = o; }
    LDS_WAIT();
}

DI void p0_prologue(const Args& a, LAS unsigned char* lds) {
    const int tid = threadIdx.x, lane = tid & 63, wave = tid >> 6;
    unsigned char* ws = a.ws;
    const int gw = blockIdx.x * NWAVE + wave, NGW = gridDim.x * NWAVE;
    const int gt = blockIdx.x * NTHR + tid, NGT = gridDim.x * NTHR;
    LAS float* scr = (LAS float*)(lds + wave * 17408);
    constexpr int T_IN = 8 * 80, T_OUT = 16 * 32, T_GLU = 8 * 16, T_QKV = 8 * 96, T_OO = 8 * 32, T_W1 = 64 * 8 * 64, T_W2 = 64 * 8 * 32;
    constexpr int NITEMS = T_IN + T_OUT + T_GLU + T_QKV + T_OO + T_W1 + T_W2;
    for (int it = gw; it < NITEMS; it += NGW) {
        int r = it;
        if (r < T_IN) { const int kb = r / 80, nb = r % 80; transpose_item_fp8(a.in[I_WIN], 1024, 2560, ws + WS_WIN, 32 * nb, scr, 128 * kb, 32 * nb, lane, 64.0f); continue; } r -= T_IN;
        if (r < T_OUT) { const int kb = r / 32, nb = r % 32; transpose_item(a.in[I_WOUT], 1024, 1024, (bf16_t*)(ws + WS_WOUT), 32 * nb, scr, 64 * kb, 32 * nb, lane); continue; } r -= T_OUT;
        if (r < T_GLU) { const int kb = r / 16, nb = r % 16; transpose_item(a.in[I_WGLU], 512, 512, (bf16_t*)(ws + WS_WGLU), 32 * nb, scr, 64 * kb, 32 * nb, lane); continue; } r -= T_GLU;
        if (r < T_QKV) { const int kb = r / 96, nb = r % 96; transpose_item_fp8(a.in[I_WQKV], 1024, 3072, ws + WS_WQKV, 32 * nb, scr, 128 * kb, 32 * nb, lane, 64.0f); continue; } r -= T_QKV;
        if (r < T_OO) { const int kb = r / 32, nb = r % 32; transpose_item_fp8(a.in[I_WO], 1024, 1024, ws + WS_WO, 32 * nb, scr, 128 * kb, 32 * nb, lane, 64.0f); continue; } r -= T_OO;
        if (r < T_W1) { const int m = r / 512, q = r % 512, kb = q / 64, nb = q % 64, n0 = 32 * nb;
            const int np = ((n0 & 1023) >> 7) * 256 + (n0 >> 10) * 128 + (n0 & 127);
            transpose_item_fp8(a.in[I_W1] + (size_t)m * 1024 * 2048, 1024, 2048, ws + WS_W1 + (size_t)m * 2048 * 1024, np, scr, 128 * kb, n0, lane, 64.0f); continue; } r -= T_W1;
        { const int m = r / 256, q = r % 256, kb = q / 32, nb = q % 32;
            transpose_item_fp8(a.in[I_W2] + (size_t)m * 1024 * 1024, 1024, 1024, ws + WS_W2 + (size_t)m * 1024 * 1024, 32 * nb, scr, 128 * kb, 32 * nb, lane, 64.0f); }
    }
    __syncthreads();
    {
        LAS float* cond = (LAS float*)lds;
        for (int i = tid; i < 3 * 1024; i += NTHR) { const int s = i >> 10, k = i & 1023; const float v = s < 2 ? a.in[I_C][s * 1024 + k] : a.in[I_CCTX][k]; cond[i] = v / (1.0f + __expf(-v)); }
        __syncthreads();
        float* modp = (float*)(ws + WS_MODP);
        for (int it = gw; it < 2 * 8 * 24; it += NGW) {
            const int l = it / 192, q = it % 192, ks = q / 24, nb = q % 24, n = nb * 256 + lane * 4;
            f32x4 acc0 = {0, 0, 0, 0}, acc1 = {0, 0, 0, 0}, acc2 = {0, 0, 0, 0};
            const float* wp = a.in[I_ADAW] + (size_t)l * 1024 * 6144 + (size_t)(ks * 128) * 6144 + n;
#pragma unroll 8
            for (int k = 0; k < 128; ++k) { const f32x4 w = *(const f32x4*)(wp + (size_t)k * 6144); const int kk = ks * 128 + k;
                acc0 += w * cond[kk]; acc1 += w * cond[1024 + kk]; acc2 += w * cond[2048 + kk]; }
            float* o = modp + ((size_t)(ks * 2 + l) * 3) * 6144 + n;
            *(f32x4*)(o) = acc0; *(f32x4*)(o + 6144) = acc1; *(f32x4*)(o + 2 * 6144) = acc2;
        }
    }
    for (int i = gt; i < 256 * 32; i += NGT) { const int pos = i >> 5, f = i & 31; const double fr = pow(10000.0, -(double)f / 32.0), ang = (double)pos * fr;
        ((f32x2*)(ws + WS_ROPE))[i] = (f32x2){(float)cos(ang), (float)sin(ang)}; }
    for (int i = gt; i < 2 * 32 * 1024; i += NGT) { const int l = i >> 15, e = (i >> 10) & 31, k = i & 1023; ((float*)(ws + WS_WRT))[i] = a.in[I_WR][(size_t)l * 32768 + k * 32 + e]; }
    for (int i = gt; i < 2 * 32 * 64; i += NGT) {
        const int dr = i >> 11, g = (i >> 6) & 31, ln = i & 63;
        const double st = exp((double)a.in[I_LSTEP][dr * 32 + g]);
        {
            const int p = ln; double lre = (double)a.in[I_LRE][(dr * 32 + g) * 64 + p]; if (lre > -1e-4) lre = -1e-4; const double lim = (double)a.in[I_LIM][(dr * 32 + g) * 64 + p];
            const double mag = exp(lre * st), ang = lim * st; double ar = mag * cos(ang), ai = mag * sin(ang);
            double pr = ar, pi = ai;
            for (int q = 0; q < 7; ++q) { const double nr = pr * pr - pi * pi, ni = 2.0 * pr * pi; pr = nr; pi = ni; }
            ((f32x4*)(ws + WS_S5A))[i] = (f32x4){(float)ar, (float)ai, (float)pr, (float)pi};
        }
        const int h = ln >> 5, cl = ln & 31;
#pragma unroll
        for (int m = 0; m < 4; ++m) {
            const int p = 32 * (m >> 1) + cl;
            double lre = (double)a.in[I_LRE][(dr * 32 + g) * 64 + p]; if (lre > -1e-4) lre = -1e-4; const double lim = (double)a.in[I_LIM][(dr * 32 + g) * 64 + p];
            const double mag = exp(lre * st), ang = lim * st, ar = mag * cos(ang), ai = mag * sin(ang);
            const double den = lre * lre + lim * lim, nre = ar - 1.0, nim = ai;
            const double cre = (nre * lre + nim * lim) / den, cim = (nim * lre - nre * lim) / den;
            float v[8];
#pragma unroll
            for (int jj = 0; jj < 8; ++jj) { const int ii = 8 * h + jj; const double br = (double)a.in[I_BRE][((size_t)(dr * 32 + g) * 64 + p) * 16 + ii], bi = (double)a.in[I_BIM][((size_t)(dr * 32 + g) * 64 + p) * 16 + ii];
                v[jj] = (m & 1) ? (float)(cre * bi + cim * br) : (float)(cre * br - cim * bi); }
            u32x4 o; o[0] = pk2(v[0], v[1]); o[1] = pk2(v[2], v[3]); o[2] = pk2(v[4], v[5]); o[3] = pk2(v[6], v[7]);
            ((u32x4*)(ws + WS_S5BF))[((dr * 32 + g) * 4 + m) * 64 + ln] = o;
        }
        const int ci = ln & 15, quad = ln >> 4;
#pragma unroll
        for (int ks = 0; ks < 4; ++ks) {
            float v[8];
#pragma unroll
            for (int jj = 0; jj < 8; ++jj) { const int kp = 32 * ks + 8 * quad + jj, p = kp >> 1;
                v[jj] = (kp & 1) ? -a.in[I_CIM][((size_t)(dr * 32 + g) * 16 + ci) * 64 + p] : a.in[I_CRE][((size_t)(dr * 32 + g) * 16 + ci) * 64 + p]; }
            u32x4 o; o[0] = pk2(v[0], v[1]); o[1] = pk2(v[2], v[3]); o[2] = pk2(v[4], v[5]); o[3] = pk2(v[6], v[7]);
            ((u32x4*)(ws + WS_S5CF))[((dr * 32 + g) * 4 + ks) * 64 + ln] = o;
        }
    }
}

DI float wave_sum(float v) {
#pragma unroll
    for (int o = 1; o < 64; o <<= 1) v += __shfl_xor(v, o);
    return v;
}
template <int MODE>
DI void row_phase(const Args& a, LAS unsigned char* lds, int layer, int nrows) {
    int tid = threadIdx.x; asm volatile("" : "+v"(tid));
    const int lane = tid & 63, wave = __builtin_amdgcn_readfirstlane(tid >> 6);
    unsigned char* ws = a.ws;
    LAS float* modl = (LAS float*)lds;
    LAS float* wrt = (LAS float*)(lds + 24576);
    LAS int* hist = (LAS int*)(lds + 24576 + 131072);
    const float* modp = (const float*)(ws + WS_MODP);
    float* modf = (float*)(ws + WS_MODF);
    const int nl = (MODE == 2) ? 1 : layer;
    const int csh = (MODE == 1) ? 3 : 0;
    const float* nwg = (MODE == 3) ? a.in[I_FNW] : a.in[I_NORMW] + (nl * 2 + (MODE == 1 ? 1 : 0)) * 1024;
    if (MODE == 0) {
        for (int i = tid; i < 3 * 2048; i += NTHR) { const int s = i / 2048, j = i % 2048, ch = j >> 10, jj = j & 1023;
            float v = a.in[I_ADAB][j];
            for (int ks = 0; ks < 8; ++ks) v += modp[((size_t)(ks * 2 + 0) * 3 + s) * 6144 + j];
            modl[(s * 2 + ch) * 1024 + jj] = ch ? nwg[jj] * (1.0f + v) : v; }
        for (int i = blockIdx.x * NTHR + tid; i < 2 * 3 * 6144; i += gridDim.x * NTHR) { const int l = i / 18432, q = i % 18432, s = q / 6144, j = q % 6144;
            float v = a.in[I_ADAB][l * 6144 + j];
            for (int ks = 0; ks < 8; ++ks) v += modp[((size_t)(ks * 2 + l) * 3 + s) * 6144 + j];
            modf[i] = v; }
    } else if (MODE != 3) {
        for (int i = tid; i < 3 * 2048; i += NTHR) { const int s = i / 2048, j = i % 2048, ch = j >> 10, jj = j & 1023;
            const float v = modf[((size_t)nl * 3 + s) * 6144 + csh * 1024 + j];
            modl[(s * 2 + ch) * 1024 + jj] = ch ? nwg[jj] * (1.0f + v) : v; }
    }
    if (MODE >= 2) for (int i = tid; i < 3 * 1024; i += NTHR) { const int s = i >> 10, j = i & 1023; modl[6144 + s * 1024 + j] = modf[((size_t)layer * 3 + s) * 6144 + 5 * 1024 + j]; }
    if (MODE == 3) for (int i = tid; i < 1024; i += NTHR) modl[9216 + i] = nwg[i];
    LAS int* slL = (LAS int*)(lds + 65536); LAS float* gkL = (LAS float*)(lds + 65536 + 4096);
    if (MODE >= 2) { const int rpb_ = nrows / gridDim.x, rb_ = blockIdx.x * rpb_;
        for (int i = tid; i < rpb_ * 4; i += NTHR) { slL[i] = ld_i((const int*)(ws + WS_RSLOT) + (size_t)rb_ * 4 + i); gkL[i] = ld_f((const float*)(ws + WS_GATE) + (size_t)rb_ * 4 + i); } }
    if (MODE == 1) {
        const float* wsrc = (const float*)(ws + WS_WRT) + (size_t)layer * 32768;
        for (int i = tid; i < 32768 / 4; i += NTHR) ((LAS f32x4*)wrt)[i] = ((const f32x4*)wsrc)[i];
        if (tid < 32) hist[tid] = 0;
    }
    __syncthreads();
    const int rpb = nrows / gridDim.x;
    const int rbase = blockIdx.x * rpb;
    bf16_t* xs = (bf16_t*)(ws + WS_XS);
    bf16_t* H = (bf16_t*)(ws + WS_H);
    if (MODE == 1) {
        LAS float* lg = (LAS float*)(lds + 24576 + 131072 + 128) + wave * 80;
        for (int rr = 2 * wave; rr < rpb; rr += 2 * NWAVE) {
            f32x4 hh[2][4]; float rstd2[2];
#pragma unroll
            for (int u = 0; u < 2; ++u) {
                const bf16_t* xrow = xs + (size_t)(rbase + rr + u) * 1024;
                float ss = 0.f;
#pragma unroll
                for (int j = 0; j < 4; ++j) { const u32x2 xw = ((const u32x2*)xrow)[64 * j + lane]; hh[u][j] = (f32x4){bflo(xw[0]), bfhi(xw[0]), bflo(xw[1]), bfhi(xw[1])}; ss += (hh[u][j][0] * hh[u][j][0] + hh[u][j][1] * hh[u][j][1]) + (hh[u][j][2] * hh[u][j][2] + hh[u][j][3] * hh[u][j][3]); }
                rstd2[u] = ss;
            }
#pragma unroll
            for (int o = 1; o < 64; o <<= 1) { rstd2[0] += __shfl_xor(rstd2[0], o); rstd2[1] += __shfl_xor(rstd2[1], o); }
#pragma unroll
            for (int u = 0; u < 2; ++u) {
                const int row = rbase + rr + u, s = row_s(row);
                const float rstd = 1.0f / sqrtf(rstd2[u] * (1.0f / 1024.0f) + 1e-6f);
#pragma unroll
                for (int j = 0; j < 4; ++j) { const f32x4 sh = *(const LAS f32x4*)(modl + (s * 2 + 0) * 1024 + 256 * j + 4 * lane), wsc = *(const LAS f32x4*)(modl + (s * 2 + 1) * 1024 + 256 * j + 4 * lane);
                    hh[u][j] = (hh[u][j] * rstd) * wsc + sh;
                    ((unsigned*)((unsigned char*)H + (size_t)row * 1024))[64 * j + lane] = pk4_fp8(hh[u][j][0], hh[u][j][1], hh[u][j][2], hh[u][j][3]); }
            }
            float acc[2][32];
#pragma unroll
            for (int e = 0; e < 32; ++e) { float s0 = 0.f, s1 = 0.f;
#pragma unroll
                for (int j = 0; j < 4; ++j) { const f32x4 w = *(const LAS f32x4*)(wrt + e * 1024 + 256 * j + 4 * lane);
                    s0 += (hh[0][j][0] * w[0] + hh[0][j][1] * w[1]) + (hh[0][j][2] * w[2] + hh[0][j][3] * w[3]);
                    s1 += (hh[1][j][0] * w[0] + hh[1][j][1] * w[1]) + (hh[1][j][2] * w[2] + hh[1][j][3] * w[3]); }
                acc[0][e] = s0; acc[1][e] = s1; }
            float r16[2][16], r8[2][8], r4[2][4], r2[2][2], r1[2];
#pragma unroll
            for (int u = 0; u < 2; ++u) {
                { const bool up = lane & 32;
#pragma unroll
                  for (int e = 0; e < 16; ++e) { const float keep = up ? acc[u][e + 16] : acc[u][e], send = up ? acc[u][e] : acc[u][e + 16]; r16[u][e] = keep + __shfl_xor(send, 32); } }
                { const bool up = lane & 16;
#pragma unroll
                  for (int e = 0; e < 8; ++e) { const float keep = up ? r16[u][e + 8] : r16[u][e], send = up ? r16[u][e] : r16[u][e + 8]; r8[u][e] = keep + __shfl_xor(send, 16); } }
                { const bool up = lane & 8;
#pragma unroll
                  for (int e = 0; e < 4; ++e) { const float keep = up ? r8[u][e + 4] : r8[u][e], send = up ? r8[u][e] : r8[u][e + 4]; r4[u][e] = keep + __shfl_xor(send, 8); } }
                { const bool up = lane & 4;
#pragma unroll
                  for (int e = 0; e < 2; ++e) { const float keep = up ? r4[u][e + 2] : r4[u][e], send = up ? r4[u][e] : r4[u][e + 2]; r2[u][e] = keep + __shfl_xor(send, 4); } }
                { const bool up = lane & 2; const float keep = up ? r2[u][1] : r2[u][0], send = up ? r2[u][0] : r2[u][1]; r1[u] = keep + __shfl_xor(send, 2); }
                r1[u] += __shfl_xor(r1[u], 1);
            }
            const int myexp = lane >> 1;
            const float bias = a.in[I_BR][layer * 32 + myexp];
            const float val0 = r1[0] + bias, val1 = r1[1] + bias;
            if (!(lane & 1)) { lg[myexp] = val0; lg[32 + myexp] = val1; }
            LDS_WAIT();
            int rank0 = 0, rank1 = 0;
#pragma unroll
            for (int q = 0; q < 8; ++q) { const f32x4 v0 = *(const LAS f32x4*)(lg + 4 * q), v1 = *(const LAS f32x4*)(lg + 32 + 4 * q);
#pragma unroll
                for (int t = 0; t < 4; ++t) { const int e2 = 4 * q + t;
                    rank0 += (v0[t] > val0 || (v0[t] == val0 && e2 < myexp)) ? 1 : 0;
                    rank1 += (v1[t] > val1 || (v1[t] == val1 && e2 < myexp)) ? 1 : 0; } }
            LAS f32x2* slot = (LAS f32x2*)(lg + 64);
            if (!(lane & 1)) { if (rank0 < 4) slot[rank0] = (f32x2){val0, __int_as_float(myexp)}; if (rank1 < 4) slot[4 + rank1] = (f32x2){val1, __int_as_float(myexp)}; }
            LDS_WAIT();
            if (lane < 2) {
                const int u = lane, row = rbase + rr + u;
                const f32x2 t0 = slot[4 * u], t1 = slot[4 * u + 1], t2 = slot[4 * u + 2], t3 = slot[4 * u + 3];
                const float e1 = __expf(t1[0] - t0[0]), e2 = __expf(t2[0] - t0[0]), e3 = __expf(t3[0] - t0[0]); const float inv = 1.0f / (1.0f + e1 + e2 + e3);
                const int x0 = __float_as_int(t0[1]), x1 = __float_as_int(t1[1]), x2 = __float_as_int(t2[1]), x3 = __float_as_int(t3[1]);
                int* sel = (int*)(ws + WS_SEL) + (size_t)row * 4; float* gt = (float*)(ws + WS_GATE) + (size_t)row * 4;
                st_i(sel, x0); st_i(sel + 1, x1); st_i(sel + 2, x2); st_i(sel + 3, x3);
                st_f(gt, inv); st_f(gt + 1, e1 * inv); st_f(gt + 2, e2 * inv); st_f(gt + 3, e3 * inv);
                atomicAdd((int*)&hist[x0], 1); atomicAdd((int*)&hist[x1], 1); atomicAdd((int*)&hist[x2], 1); atomicAdd((int*)&hist[x3], 1);
            }
            LDS_WAIT();
        }
    } else {
        const bf16_t* Y2 = (const bf16_t*)(ws + WS_Y2);
        for (int rr = 2 * wave; rr < rpb; rr += 2 * NWAVE) {
            f32x4 v[2][4]; int sl[2][4]; float gk[2][4];
#pragma unroll
            for (int u = 0; u < 2; ++u) {
                const int row = rbase + rr + u;
                if (MODE == 0) { const float* xrow = (row < NLAT ? a.in[I_X] + (size_t)row * 1024 : a.in[I_CTX] + (size_t)(row - NLAT) * 1024);
#pragma unroll
                    for (int j = 0; j < 4; ++j) v[u][j] = ((const f32x4*)xrow)[64 * j + lane]; }
                else { const bf16_t* xrow = xs + (size_t)row * 1024;
#pragma unroll
                    for (int j = 0; j < 4; ++j) { const u32x2 xw = ((const u32x2*)xrow)[64 * j + lane]; v[u][j] = (f32x4){bflo(xw[0]), bfhi(xw[0]), bflo(xw[1]), bfhi(xw[1])}; } }
                if (MODE >= 2) {
#pragma unroll
                    for (int k = 0; k < 4; ++k) { sl[u][k] = __builtin_amdgcn_readfirstlane(slL[(rr + u) * 4 + k]); gk[u][k] = __int_as_float(__builtin_amdgcn_readfirstlane(__float_as_int(gkL[(rr + u) * 4 + k]))); }
                }
            }
            if (MODE >= 2) {
                unsigned yw[2][4][4];
#pragma unroll
                for (int u = 0; u < 2; ++u)
#pragma unroll
                    for (int k = 0; k < 4; ++k) { const unsigned* yr = (const unsigned*)((const unsigned char*)Y2 + (size_t)sl[u][k] * 1024);
#pragma unroll
                        for (int j = 0; j < 4; ++j) yw[u][k][j] = yr[64 * j + lane]; }
#pragma unroll
                for (int u = 0; u < 2; ++u) {
                    const int row = rbase + rr + u, s = row_s(row);
#pragma unroll
                    for (int j = 0; j < 4; ++j) { f32x4 y = {0.f, 0.f, 0.f, 0.f};
#pragma unroll
                        for (int k = 0; k < 4; ++k) { const unsigned w = yw[u][k][j]; const float g = gk[u][k] * 0.0625f; const f32x2 lo = __builtin_amdgcn_cvt_pk_f32_fp8(w, false), hi = __builtin_amdgcn_cvt_pk_f32_fp8(w, true); y[0] += g * lo[0]; y[1] += g * lo[1]; y[2] += g * hi[0]; y[3] += g * hi[1]; }
                        const f32x4 g2 = *(const LAS f32x4*)(modl + 6144 + s * 1024 + 256 * j + 4 * lane); v[u][j] += g2 * y;
                        if (MODE == 2) { u32x2 o; o[0] = pk2(v[u][j][0], v[u][j][1]); o[1] = pk2(v[u][j][2], v[u][j][3]); ((u32x2*)(xs + (size_t)row * 1024))[64 * j + lane] = o; } }
                }
            }
            float ss2[2];
#pragma unroll
            for (int u = 0; u < 2; ++u) { float ss = 0.f;
#pragma unroll
                for (int j = 0; j < 4; ++j) ss += (v[u][j][0] * v[u][j][0] + v[u][j][1] * v[u][j][1]) + (v[u][j][2] * v[u][j][2] + v[u][j][3] * v[u][j][3]);
                ss2[u] = ss; }
#pragma unroll
            for (int o = 1; o < 64; o <<= 1) { ss2[0] += __shfl_xor(ss2[0], o); ss2[1] += __shfl_xor(ss2[1], o); }
#pragma unroll
            for (int u = 0; u < 2; ++u) {
                const int row = rbase + rr + u, s = row_s(row);
                const float rstd = __builtin_amdgcn_rsqf(ss2[u] * (1.0f / 1024.0f) + 1e-6f);
#pragma unroll
                for (int j = 0; j < 4; ++j) {
                    if (MODE == 3) { const f32x4 w = *(const LAS f32x4*)(modl + 9216 + 256 * j + 4 * lane); __builtin_nontemporal_store(v[u][j] * rstd * w, (f32x4*)(a.out + (size_t)row * 1024) + 64 * j + lane); }
                    else { const f32x4 sh = *(const LAS f32x4*)(modl + (s * 2 + 0) * 1024 + 256 * j + 4 * lane), wsc = *(const LAS f32x4*)(modl + (s * 2 + 1) * 1024 + 256 * j + 4 * lane);
                        const f32x4 hv = (v[u][j] * rstd) * wsc + sh;
                        if (true) { ((unsigned*)((unsigned char*)H + (size_t)row * 1024))[64 * j + lane] = pk4_fp8(hv[0], hv[1], hv[2], hv[3]); }
                        else { u32x2 o; o[0] = pk2(hv[0], hv[1]); o[1] = pk2(hv[2], hv[3]); ((u32x2*)(H + (size_t)row * 1024))[64 * j + lane] = o; } }
                }
            }
        }
    }
    if (MODE == 1) { __syncthreads(); if (tid < 32) st_i((int*)(ws + WS_CNT) + blockIdx.x * 32 + tid, hist[tid]); }
    __syncthreads();
}

DI void router_phase(const Args& a, LAS unsigned char* lds, int layer, int nrows) {
    int tid = threadIdx.x; asm volatile("" : "+v"(tid));
    const int lane = tid & 63, wave = __builtin_amdgcn_readfirstlane(tid >> 6);
    unsigned char* ws = a.ws;
    constexpr int RS = 2064;
    LAS float* modl = (LAS float*)lds;
    LAS unsigned char* hiP = lds + 24576;
    LAS unsigned char* loP = hiP + 32 * RS;
    LAS float* part = (LAS float*)hiP;
    LAS float* lg = part + 8192 + wave * 160;
    LAS int* hist = (LAS int*)(loP + 32 * RS);
    const float* modf = (const float*)(ws + WS_MODF);
    const float* nwg = a.in[I_NORMW] + (layer * 2 + 1) * 1024;
    for (int i = tid; i < 3 * 2048; i += NTHR) { const int s = i / 2048, j = i % 2048, ch = j >> 10, jj = j & 1023;
        const float v = modf[((size_t)layer * 3 + s) * 6144 + 3 * 1024 + j];
        modl[(s * 2 + ch) * 1024 + jj] = ch ? nwg[jj] * (1.0f + v) : v; }
    if (tid < 32) hist[tid] = 0;
    bf16x8 whi[8], wlo[8];
    { const float* wsrc = (const float*)(ws + WS_WRT) + (size_t)layer * 32768 + (lane & 31) * 1024 + 128 * wave + 8 * (lane >> 5);
#pragma unroll
      for (int t = 0; t < 8; ++t) { const f32x4 w0 = *(const f32x4*)(wsrc + 16 * t), w1 = *(const f32x4*)(wsrc + 16 * t + 4);
          u32x4 h, l;
          h[0] = pk2(w0[0], w0[1]); h[1] = pk2(w0[2], w0[3]); h[2] = pk2(w1[0], w1[1]); h[3] = pk2(w1[2], w1[3]);
          l[0] = pk2(w0[0] - bflo(h[0]), w0[1] - bfhi(h[0])); l[1] = pk2(w0[2] - bflo(h[1]), w0[3] - bfhi(h[1]));
          l[2] = pk2(w1[0] - bflo(h[2]), w1[1] - bfhi(h[2])); l[3] = pk2(w1[2] - bflo(h[3]), w1[3] - bfhi(h[3]));
          whi[t] = __builtin_bit_cast(bf16x8, h); wlo[t] = __builtin_bit_cast(bf16x8, l); } }
    const int rpb = nrows / gridDim.x, rbase = blockIdx.x * rpb, ntile = (rpb + 31) >> 5;
    const bf16_t* xs = (const bf16_t*)(ws + WS_XS);
    unsigned char* H = ws + WS_H;
    const int e2 = lane & 15, tk = lane >> 4;
    const float bias0 = a.in[I_BR][layer * 32 + e2], bias1 = a.in[I_BR][layer * 32 + 16 + e2];
    __syncthreads();
#pragma unroll 1
    for (int tile = 0; tile < ntile; ++tile) {
        u32x2 xw[4][4];
#pragma unroll
        for (int u = 0; u < 4; ++u) { const int rl = 32 * tile + 4 * wave + u; const bool ok = rl < rpb;
#pragma unroll
            for (int j = 0; j < 4; ++j) xw[u][j] = ok ? ((const u32x2*)(xs + (size_t)(rbase + rl) * 1024))[64 * j + lane] : (u32x2){0u, 0u}; }
        float ss[4];
#pragma unroll
        for (int u = 0; u < 4; ++u) { float t = 0.f;
#pragma unroll
            for (int j = 0; j < 4; ++j) { const float x0 = bflo(xw[u][j][0]), x1 = bfhi(xw[u][j][0]), x2 = bflo(xw[u][j][1]), x3 = bfhi(xw[u][j][1]); t += (x0 * x0 + x1 * x1) + (x2 * x2 + x3 * x3); }
            ss[u] = t; }
#pragma unroll
        for (int o = 1; o < 64; o <<= 1) {
#pragma unroll
            for (int u = 0; u < 4; ++u) ss[u] += __shfl_xor(ss[u], o); }
#pragma unroll
        for (int u = 0; u < 4; ++u) {
            const int rl = 32 * tile + 4 * wave + u, row = rbase + rl, s = row_s(row); const bool ok = rl < rpb;
            const float rstd = 1.0f / sqrtf(ss[u] * (1.0f / 1024.0f) + 1e-6f);
#pragma unroll
            for (int j = 0; j < 4; ++j) { const f32x4 sh = *(const LAS f32x4*)(modl + (s * 2 + 0) * 1024 + 256 * j + 4 * lane), wsc = *(const LAS f32x4*)(modl + (s * 2 + 1) * 1024 + 256 * j + 4 * lane);
                const f32x4 xv = {bflo(xw[u][j][0]), bfhi(xw[u][j][0]), bflo(xw[u][j][1]), bfhi(xw[u][j][1])};
                const f32x4 hv = (xv * rstd) * wsc + sh;
                u32x2 ph, pl; ph[0] = pk2(hv[0], hv[1]); ph[1] = pk2(hv[2], hv[3]);
                pl[0] = pk2(hv[0] - bflo(ph[0]), hv[1] - bfhi(ph[0])); pl[1] = pk2(hv[2] - bflo(ph[1]), hv[3] - bfhi(ph[1]));
                *(LAS u32x2*)(hiP + (4 * wave + u) * RS + (256 * j + 4 * lane) * 2) = ph;
                *(LAS u32x2*)(loP + (4 * wave + u) * RS + (256 * j + 4 * lane) * 2) = pl;
                if (ok) ((unsigned*)(H + (size_t)row * 1024))[64 * j + lane] = pk4_fp8(hv[0], hv[1], hv[2], hv[3]); }
        }
        __syncthreads();
        f32x16 acc0 = zero16(), acc1 = zero16();
        { const int aoff = (lane & 31) * RS + (128 * wave + 8 * (lane >> 5)) * 2;
#pragma unroll
          for (int hf = 0; hf < 2; ++hf) { bf16x8 ah[4], al[4];
#pragma unroll
              for (int t = 0; t < 4; ++t) { ah[t] = *(const LAS bf16x8*)(hiP + aoff + (4 * hf + t) * 32); al[t] = *(const LAS bf16x8*)(loP + aoff + (4 * hf + t) * 32); }
#pragma unroll
              for (int t = 0; t < 4; ++t) { acc0 = MFMA32(ah[t], whi[4 * hf + t], acc0); acc1 = MFMA32(ah[t], wlo[4 * hf + t], acc1); acc0 = MFMA32(al[t], whi[4 * hf + t], acc0); } } }
        __syncthreads();
#pragma unroll
        for (int r = 0; r < 16; ++r) { const int tok = (r & 3) + 8 * (r >> 2) + 4 * (lane >> 5); part[(wave * 32 + tok) * 32 + (lane & 31)] = acc0[r] + acc1[r]; }
        __syncthreads();
        { const int tokl = 4 * wave + tk;
          float v0 = bias0, v1 = bias1;
#pragma unroll
          for (int w = 0; w < 8; ++w) { v0 += part[(w * 32 + tokl) * 32 + e2]; v1 += part[(w * 32 + tokl) * 32 + 16 + e2]; }
          lg[tk * 32 + e2] = v0; lg[tk * 32 + 16 + e2] = v1;
          LDS_WAIT();
          int rank0 = 0, rank1 = 0;
#pragma unroll
          for (int q = 0; q < 8; ++q) { const f32x4 vv = *(const LAS f32x4*)(lg + tk * 32 + 4 * q);
#pragma unroll
              for (int t = 0; t < 4; ++t) { const int ex = 4 * q + t;
                  rank0 += (vv[t] > v0 || (vv[t] == v0 && ex < e2)) ? 1 : 0;
                  rank1 += (vv[t] > v1 || (vv[t] == v1 && ex < e2 + 16)) ? 1 : 0; } }
          LAS f32x2* slot = (LAS f32x2*)(lg + 128) + tk * 4;
          if (rank0 < 4) slot[rank0] = (f32x2){v0, __int_as_float(e2)};
          if (rank1 < 4) slot[rank1] = (f32x2){v1, __int_as_float(e2 + 16)};
          LDS_WAIT();
          const int rl = 32 * tile + tokl;
          if (e2 == 0 && rl < rpb) {
              const int row = rbase + rl;
              const f32x2 t0 = slot[0], t1 = slot[1], t2 = slot[2], t3 = slot[3];
              const float e1 = __expf(t1[0] - t0[0]), e2v = __expf(t2[0] - t0[0]), e3 = __expf(t3[0] - t0[0]); const float inv = 1.0f / (1.0f + e1 + e2v + e3);
              const int x0 = __float_as_int(t0[1]), x1 = __float_as_int(t1[1]), x2 = __float_as_int(t2[1]), x3 = __float_as_int(t3[1]);
              int* sel = (int*)(ws + WS_SEL) + (size_t)row * 4; float* gt = (float*)(ws + WS_GATE) + (size_t)row * 4;
              st_i(sel, x0); st_i(sel + 1, x1); st_i(sel + 2, x2); st_i(sel + 3, x3);
              st_f(gt, inv); st_f(gt + 1, e1 * inv); st_f(gt + 2, e2v * inv); st_f(gt + 3, e3 * inv);
              atomicAdd((int*)&hist[x0], 1); atomicAdd((int*)&hist[x1], 1); atomicAdd((int*)&hist[x2], 1); atomicAdd((int*)&hist[x3], 1);
          } }
        __syncthreads();
    }
    if (tid < 32) st_i((int*)(ws + WS_CNT) + blockIdx.x * 32 + tid, hist[tid]);
    __syncthreads();
}

typedef int i32x4_t __attribute__((ext_vector_type(4)));
DI void slots_phase(const Args& a, LAS unsigned char* lds, int nrows) {
    const int tid = threadIdx.x; unsigned char* ws = a.ws;
    LAS int* tot = (LAS int*)lds; LAS int* bef = tot + 32; LAS int* pst = tot + 64; LAS int* sell = tot + 128;
    const int* cnt = (const int*)(ws + WS_CNT);
    const int rpb = nrows / gridDim.x, rbase = blockIdx.x * rpb;
    {
        LAS int* ptot = sell + 1024; LAS int* pbef = ptot + 512;
        const int e = tid & 31, part = tid >> 5;
        int cv[16];
#pragma unroll
        for (int k = 0; k < 16; ++k) cv[k] = ld_i(cnt + (part * 16 + k) * 32 + e);
        int t = 0, bsum = 0;
#pragma unroll
        for (int k = 0; k < 16; ++k) { t += cv[k]; if (part * 16 + k < (int)blockIdx.x) bsum += cv[k]; }
        ptot[part * 32 + e] = t; pbef[part * 32 + e] = bsum;
        for (int i = tid; i < rpb * 4; i += NTHR) sell[i] = ld_i((const int*)(ws + WS_SEL) + (size_t)rbase * 4 + i);
        __syncthreads();
        if (tid < 32) { int tt = 0, bb2 = 0; for (int p = 0; p < 16; ++p) { tt += ptot[p * 32 + tid]; bb2 += pbef[p * 32 + tid]; } tot[tid] = tt; bef[tid] = bb2; }
    }
    __syncthreads();
    if (tid < 32) { int p = 0;
#pragma unroll
        for (int e = 0; e < 31; ++e) p += (e < tid) ? ((tot[e] + 255) & ~255) : 0;
        pst[tid] = p; }
    __syncthreads();
    int* stok = (int*)(ws + WS_STOK); int* rsl = (int*)(ws + WS_RSLOT);
    for (int i = tid; i < rpb * 4; i += NTHR) {
        const int e = sell[i]; int rank = 0;
        for (int r = 0; r < (i >> 2); ++r) { const i32x4_t v = ((const LAS i32x4_t*)sell)[r]; rank += (v[0] == e ? 1 : 0) + (v[1] == e ? 1 : 0) + (v[2] == e ? 1 : 0) + (v[3] == e ? 1 : 0); }
        const int pos = pst[e] + bef[e] + rank;
        st_i(stok + pos, rbase + (i >> 2)); st_i(rsl + (size_t)rbase * 4 + i, pos); }
    if (blockIdx.x < 32) { const int e = blockIdx.x; const int lo = pst[e] + tot[e], hi = pst[e] + ((tot[e] + 255) & ~255); for (int i = lo + tid; i < hi; i += NTHR) st_i(stok + i, 0); }
    if (blockIdx.x == 32 && tid < 32) st_i((int*)(ws + WS_ETOT) + tid, tot[tid]);
    __syncthreads();
}

namespace pg8 {
constexpr int BM = 256, BK = 64, HALF = 128, HTB = HALF * BK * 2, STAGE_BYTES = 8 * HTB, NXCD = 8, WGM = 8;
__host__ __device__ __forceinline__ int lds_byte(int r, int c) { const int st = (r >> 4) * 2 + (c >> 5), rr = r & 15, cc = c & 31, ob = rr * 64 + cc * 2; return st * 1024 + (ob ^ (((ob >> 9) & 1) << 5)); }
__host__ __device__ __forceinline__ void stage_rc(int b, int& R, int& C) { const int st = b / 1024, sb = b % 1024, swz = sb ^ (((sb >> 9) & 1) << 5); R = (st >> 1) * 16 + swz / 64; C = (st & 1) * 32 + (swz % 64) / 2; }
__host__ __device__ __forceinline__ int perm32(int rho) { const int n = rho >> 4, i = rho & 15; return 8 * (i >> 2) + 4 * n + (i & 3); }

struct Unit { unsigned boff; int arow0; int orow0; int pn; int e; };

struct DenseOrder {
    int nM, nN, nwg, G, c; const void* Bt; unsigned btile; const LAS int* rowtab;
    DI void init(int M, int N, int K, const void* Bt_, int G_, int c_) { nM = M / BM; nN = N / BM; nwg = nM * nN; G = G_; c = c_; Bt = Bt_; btile = (unsigned)(BM * K * 2); rowtab = nullptr; }
    DI void fill_rowtab(LAS int* rt) { Unit u; for (int i = 0; next(i, u); ++i) if (threadIdx.x < 256) rt[i * 256 + threadIdx.x] = u.arow0 + (int)threadIdx.x; rowtab = rt; __syncthreads(); }
    DI const void* wbase() const { return Bt; }
    DI bool next(int i, Unit& u) const {
        const long L = (long)i * G + c; if (L >= nwg) return false;
        int wgid = (int)L; { const int q = nwg / NXCD, r = nwg % NXCD, xcd = wgid % NXCD, off = wgid / NXCD; wgid = (xcd < r ? xcd * (q + 1) : r * (q + 1) + (xcd - r) * q) + off; }
        const int nig = WGM * nN, gid = wgid / nig, fm = gid * WGM, gsz = (nM - fm) < WGM ? (nM - fm) : WGM;
        const int pm = fm + ((wgid % nig) % gsz), pn = (wgid % nig) / gsz;
        u.boff = (unsigned)pn * btile; u.arow0 = pm * BM; u.orow0 = pm * BM; u.pn = pn; u.e = 0; return true;
    }
    DI int arow(int i, int r) const { return rowtab[i * 256 + r]; }
};
struct MoeOrder {
    int ntile, NPN, G, c; const void* W; unsigned wexp, btile; const LAS int* tile_e; const LAS int* tile_s0; const LAS int* rowtab;
    DI const void* wbase() const { return W; }
    DI int tile_of(int i, int& pn) const { const int x = c & 7, j = c >> 3, TX = (ntile + 7) >> 3, u = i * (G >> 3) + j, tl = u / NPN; pn = u % NPN; const int t = x * TX + tl; return (tl < TX && t < ntile) ? t : -1; }
    DI bool next(int i, Unit& u) const {
        int pn; const int t = tile_of(i, pn); if (t < 0) return false;
        const int e = __builtin_amdgcn_readfirstlane(tile_e[t]), s0 = __builtin_amdgcn_readfirstlane(tile_s0[t]);
        u.boff = (unsigned)e * wexp + (unsigned)pn * btile; u.arow0 = s0; u.orow0 = s0; u.pn = pn; u.e = e; return true;
    }
    DI int arow(int i, int r) const { return rowtab[i * 256 + r]; }
};

typedef int i32x8 __attribute__((ext_vector_type(8)));
typedef int i32x4 __attribute__((ext_vector_type(4)));
template <bool GATHER, bool FP8, int SA, int SB, int PROBEK = 0, class Epi, class Sched>
DI void gemm_phase(LAS unsigned char* lds, const void* Amat, int K, const Sched& S, const Epi& E) {
    const int tid = threadIdx.x, wid = __builtin_amdgcn_readfirstlane(tid >> 6), lane = tid & 63, wr = wid >> 2, wc = wid & 3, fr = lane & 15, fq = lane >> 4;
    const int nt = K / BK;
    unsigned rcpack = 0u; unsigned voffB[2], voffA[2];
#pragma unroll
    for (int i = 0; i < 2; ++i) { int R, C; stage_rc(tid * 16 + i * 8192, R, C); rcpack |= ((unsigned)R | ((unsigned)C << 8)) << (16 * i); const int Rb = Epi::PERM ? ((R & ~31) + perm32(R & 31)) : R; voffB[i] = (unsigned)(Rb * K + C) * 2u; voffA[i] = (unsigned)(R * K + C) * 2u; }
    const unsigned kstep = (unsigned)(BK * 2);
    const unsigned hstep = (unsigned)(HALF * K * 2);
    const unsigned ldsw = (unsigned)wid * 1024u;
    const int aoff = lds_byte(wr * 64 + fr, fq * 8), boff = lds_byte(wc * 32 + fr, fq * 8);
    const __amdgpu_buffer_rsrc_t rsA = __builtin_amdgcn_make_buffer_rsrc((void*)Amat, (short)0, PROBEK == 1 ? 0 : 0x7fffffff, 0x00020000);
    const __amdgpu_buffer_rsrc_t rsB = __builtin_amdgcn_make_buffer_rsrc((void*)S.wbase(), (short)0, PROBEK == 1 ? 0 : 0x7fffffff, 0x00020000);
#define PG8_SA(b, h) (((b) * 2 + (h)) * HTB)
#define PG8_SB(b, h) ((4 + (b) * 2 + (h)) * HTB)
#define PG8_STAGEB(bufoff, soff) do { const int _so = __builtin_amdgcn_readfirstlane((int)(soff)); _Pragma("unroll") for (int _i = 0; _i < 2; ++_i) \
        __builtin_amdgcn_raw_ptr_buffer_load_lds(rsB, (LAS void*)(lds + (bufoff) + ldsw + _i * 8192), 16, (int)voffB[_i], _so, 0, 0); } while (0)
#define PG8_STAGEA(bufoff, soff, v0, v1) do { const int _so = __builtin_amdgcn_readfirstlane((int)(soff)); \
        __builtin_amdgcn_raw_ptr_buffer_load_lds(rsA, (LAS void*)(lds + (bufoff) + ldsw), 16, (int)(v0), _so, 0, 0); \
        __builtin_amdgcn_raw_ptr_buffer_load_lds(rsA, (LAS void*)(lds + (bufoff) + ldsw + 8192), 16, (int)(v1), _so, 0, 0); } while (0)
#define PG8_LDA(dst, b, h) do { _Pragma("unroll") for (int m = 0; m < 4; ++m) { const i32x4 _lo = *(const LAS i32x4*)(lds + PG8_SA(b, h) + aoff + m * 2048), _hi = *(const LAS i32x4*)(lds + PG8_SA(b, h) + aoff + m * 2048 + 1024); dst[m] = __builtin_shufflevector(_lo, _hi, 0, 1, 2, 3, 4, 5, 6, 7); } } while (0)
#define PG8_LDB(dst, b, h) do { _Pragma("unroll") for (int n = 0; n < 2; ++n) { const i32x4 _lo = *(const LAS i32x4*)(lds + PG8_SB(b, h) + boff + n * 2048), _hi = *(const LAS i32x4*)(lds + PG8_SB(b, h) + boff + n * 2048 + 1024); dst[n] = __builtin_shufflevector(_lo, _hi, 0, 1, 2, 3, 4, 5, 6, 7); } } while (0)
#define PG8_LOH(x) __builtin_bit_cast(bf16x8, __builtin_shufflevector((x), (x), 0, 1, 2, 3))
#define PG8_HIH(x) __builtin_bit_cast(bf16x8, __builtin_shufflevector((x), (x), 4, 5, 6, 7))
#define PG8_MMA(ai, bj, At, Bt) do { if constexpr (PROBEK == 2) { _Pragma("unroll") for (int m = 0; m < 4; ++m) asm volatile("" :: "v"(At[m])); _Pragma("unroll") for (int n = 0; n < 2; ++n) asm volatile("" :: "v"(Bt[n])); } else { __builtin_amdgcn_s_setprio(1); _Pragma("unroll") for (int m = 0; m < 4; ++m) _Pragma("unroll") for (int n = 0; n < 2; ++n) { \
        if constexpr (FP8) acc[ai][bj][m][n] = __builtin_amdgcn_mfma_scale_f32_16x16x128_f8f6f4(Bt[n], At[m], acc[ai][bj][m][n], 0, 0, 0, SB * 0x01010101, 0, SA * 0x01010101); \
        else { acc[ai][bj][m][n] = __builtin_amdgcn_mfma_f32_16x16x32_bf16(PG8_LOH(Bt[n]), PG8_LOH(At[m]), acc[ai][bj][m][n], 0, 0, 0); \
               acc[ai][bj][m][n] = __builtin_amdgcn_mfma_f32_16x16x32_bf16(PG8_HIH(Bt[n]), PG8_HIH(At[m]), acc[ai][bj][m][n], 0, 0, 0); } } __builtin_amdgcn_s_setprio(0); } } while (0)
#define PG8_LSTAGEA(...) PG8_STAGEA(__VA_ARGS__)
#define PG8_LSTAGEB(...) PG8_STAGEB(__VA_ARGS__)
#define PG8_WAIT_V(n) asm volatile("s_waitcnt vmcnt(" #n ")" ::: "memory")
#define PG8_WAIT_L(n) asm volatile("s_waitcnt lgkmcnt(" #n ")" ::: "memory")
#define PG8_BAR __builtin_amdgcn_s_barrier()
#define PG8_SCHED __builtin_amdgcn_sched_barrier(0)
    Unit cur, nxt; int ui = 0;
    if (!S.next(0, cur)) return;
    unsigned vc[2][2];
    unsigned ubase = 0u;
#define PG8_AOFF(unit, idx) do { if constexpr (GATHER) { _Pragma("unroll") for (int _h = 0; _h < 2; ++_h) _Pragma("unroll") for (int _i = 0; _i < 2; ++_i) { \
            const unsigned _R = (rcpack >> (16 * _i)) & 0xffu, _C = (rcpack >> (16 * _i + 8)) & 0xffu; vc[_h][_i] = ((unsigned)S.arow((idx), _h * HALF + (int)_R) * (unsigned)K + _C) * 2u; } } \
        else { ubase = (unsigned)(unit).arow0 * (unsigned)K * 2u; vc[0][0] = voffA[0]; vc[0][1] = voffA[1]; vc[1][0] = voffA[0] + hstep; vc[1][1] = voffA[1] + hstep; } } while (0)
    PG8_AOFF(cur, 0);
    f32x4 acc[2][2][4][2];
#pragma unroll
    for (int a_ = 0; a_ < 2; ++a_)
#pragma unroll
        for (int b_ = 0; b_ < 2; ++b_)
#pragma unroll
            for (int m = 0; m < 4; ++m)
#pragma unroll
                for (int n = 0; n < 2; ++n) { f32x4 z_ = {0.f, 0.f, 0.f, 0.f}; if (FP8) asm volatile("" : "+v"(z_)); acc[a_][b_][m][n] = z_; }
    i32x8 At[4], B0[2], B1[2];
    unsigned cB = cur.boff;
    PG8_STAGEB(PG8_SB(0, 0), cB); PG8_STAGEB(PG8_SB(0, 1), cB + hstep); PG8_STAGEA(PG8_SA(0, 0), ubase, vc[0][0], vc[0][1]); PG8_STAGEA(PG8_SA(0, 1), ubase, vc[1][0], vc[1][1]);
    if (wr == 1) PG8_BAR;
    PG8_WAIT_V(2); PG8_BAR;
    PG8_STAGEB(PG8_SB(1, 0), cB + kstep); PG8_STAGEA(PG8_SA(1, 0), ubase + kstep, vc[0][0], vc[0][1]); PG8_STAGEB(PG8_SB(1, 1), cB + hstep + kstep);
    PG8_WAIT_V(6); PG8_BAR;
    for (;;) {
        const bool has_next = S.next(ui + 1, nxt);
        const unsigned nB = has_next ? nxt.boff : cB;
#pragma unroll 1
        for (int t = 0; t < nt; t += 2) {
            const bool last = (t == nt - 2);
            const unsigned k1 = (unsigned)(t + 1) * kstep;
            const unsigned k2 = last ? 0u : (unsigned)(t + 2) * kstep, k3 = k2 + kstep;
            const unsigned b2 = last ? nB : cB + (unsigned)(t + 2) * kstep, b3 = b2 + kstep;
            PG8_LDB(B0, 0, 0); PG8_LDB(B1, 0, 1); PG8_SCHED; PG8_LDA(At, 0, 0); PG8_LSTAGEA(PG8_SA(1, 1), ubase + k1, vc[1][0], vc[1][1]);
            PG8_WAIT_V(8); PG8_WAIT_L(0); PG8_BAR; PG8_MMA(0, 0, At, B0); PG8_MMA(0, 1, At, B1); PG8_BAR; PG8_SCHED;
            if (last && has_next) { PG8_AOFF(nxt, ui + 1); }
            PG8_LDA(At, 0, 1); PG8_LSTAGEB(PG8_SB(0, 0), b2); PG8_LSTAGEB(PG8_SB(0, 1), b2 + hstep); PG8_LSTAGEA(PG8_SA(0, 0), ubase + k2, vc[0][0], vc[0][1]);
            PG8_WAIT_V(8); PG8_WAIT_L(0); PG8_BAR; PG8_MMA(1, 0, At, B0); PG8_MMA(1, 1, At, B1); PG8_BAR; PG8_SCHED;
            PG8_LDB(B0, 1, 0); PG8_LDB(B1, 1, 1); PG8_SCHED; PG8_LDA(At, 1, 0); PG8_LSTAGEA(PG8_SA(0, 1), ubase + k2, vc[1][0], vc[1][1]);
            PG8_WAIT_V(8); PG8_WAIT_L(0); PG8_BAR; PG8_MMA(0, 0, At, B0); PG8_MMA(0, 1, At, B1); PG8_BAR; PG8_SCHED;
            PG8_LDA(At, 1, 1); PG8_LSTAGEB(PG8_SB(1, 0), b3); PG8_LSTAGEB(PG8_SB(1, 1), b3 + hstep); PG8_LSTAGEA(PG8_SA(1, 0), ubase + k3, vc[0][0], vc[0][1]);
            PG8_WAIT_V(8); PG8_WAIT_L(0); PG8_BAR; PG8_MMA(1, 0, At, B0); PG8_MMA(1, 1, At, B1); PG8_BAR; PG8_SCHED;
        }
        if (wr == 0) PG8_BAR;
        E(acc, cur, wr, wc, fr, fq);
        if (!has_next) break;
#pragma unroll
        for (int a_ = 0; a_ < 2; ++a_)
#pragma unroll
            for (int b_ = 0; b_ < 2; ++b_)
#pragma unroll
                for (int m = 0; m < 4; ++m)
#pragma unroll
                    for (int n = 0; n < 2; ++n) { f32x4 z_ = {0.f, 0.f, 0.f, 0.f}; if (FP8) asm volatile("" : "+v"(z_)); acc[a_][b_][m][n] = z_; }
        cur = nxt; cB = nB; ++ui;
        if (wr == 1) PG8_BAR;
    }
    PG8_WAIT_V(0);
    PG8_BAR;
#undef PG8_SA
#undef PG8_SB
#undef PG8_STAGEA
#undef PG8_STAGEB
#undef PG8_LSTAGEA
#undef PG8_LSTAGEB
#undef PG8_LDA
#undef PG8_LDB
#undef PG8_MMA
#undef PG8_LOH
#undef PG8_HIH
#undef PG8_WAIT_V
#undef PG8_WAIT_L
#undef PG8_BAR
#undef PG8_SCHED
#undef PG8_AOFF
}

struct EpiBf16 {
    static constexpr bool PERM = true;
    bf16_t* O; int ldc;
    DI void operator()(const f32x4 (&acc)[2][2][4][2], const Unit& u, int wr, int wc, int fr, int fq) const {
        const int row0 = u.orow0 + wr * 64 + fr, col0 = u.pn * BM + wc * 32 + 8 * fq;
#pragma unroll
        for (int ai = 0; ai < 2; ++ai)
#pragma unroll
            for (int m = 0; m < 4; ++m) { bf16_t* rowp = O + (size_t)(row0 + ai * HALF + m * 16) * ldc + col0;
#pragma unroll
                for (int bj = 0; bj < 2; ++bj) { const f32x4 v0 = acc[ai][bj][m][0], v1 = acc[ai][bj][m][1];
                    u32x4 w; w[0] = pk2(v0[0], v0[1]); w[1] = pk2(v0[2], v0[3]); w[2] = pk2(v1[0], v1[1]); w[3] = pk2(v1[2], v1[3]);
                    *(u32x4*)(rowp + bj * HALF) = w; } }
    }
};
struct EpiGlu {
    static constexpr bool PERM = true;
    const bf16_t* YG; bf16_t* AR;
    DI void operator()(const f32x4 (&acc)[2][2][4][2], const Unit& u, int wr, int wc, int fr, int fq) const {
        const int row0 = u.orow0 + wr * 64 + fr, col0 = u.pn * BM + wc * 32 + 8 * fq;
#pragma unroll
        for (int ai = 0; ai < 2; ++ai)
#pragma unroll
            for (int m = 0; m < 4; ++m) { const size_t r = (size_t)(row0 + ai * HALF + m * 16);
#pragma unroll
                for (int bj = 0; bj < 2; ++bj) { const f32x4 v0 = acc[ai][bj][m][0], v1 = acc[ai][bj][m][1];
                    const u32x4 y = *(const u32x4*)(YG + r * 512 + col0 + bj * HALF);
                    u32x4 w; w[0] = pk2(bflo(y[0]) * sigmoidf_(v0[0]), bfhi(y[0]) * sigmoidf_(v0[1])); w[1] = pk2(bflo(y[1]) * sigmoidf_(v0[2]), bfhi(y[1]) * sigmoidf_(v0[3]));
                    w[2] = pk2(bflo(y[2]) * sigmoidf_(v1[0]), bfhi(y[2]) * sigmoidf_(v1[1])); w[3] = pk2(bflo(y[3]) * sigmoidf_(v1[2]), bfhi(y[3]) * sigmoidf_(v1[3]));
                    *(u32x4*)(AR + r * 1024 + col0 + bj * HALF) = w; } }
    }
};
template <bool XIN16>
struct EpiResid {
    static constexpr bool PERM = true;
    const float* xlat; const float* xctx; bf16_t* XS; const float* gatev;
    DI void operator()(const f32x4 (&acc)[2][2][4][2], const Unit& u, int wr, int wc, int fr, int fq) const {
        const int row0 = u.orow0 + wr * 64 + fr, col0 = u.pn * BM + wc * 32 + 8 * fq;
        const int s = row_s(u.orow0);
        f32x4 gv[2][2];
#pragma unroll
        for (int bj = 0; bj < 2; ++bj)
#pragma unroll
            for (int n = 0; n < 2; ++n) gv[bj][n] = *(const f32x4*)(gatev + (size_t)s * 6144 + col0 + bj * HALF + n * 4);
#pragma unroll
        for (int ai = 0; ai < 2; ++ai)
#pragma unroll
            for (int m = 0; m < 4; ++m) { const int r = row0 + ai * HALF + m * 16;
                bf16_t* xo = XS + (size_t)r * 1024 + col0;
#pragma unroll
                for (int bj = 0; bj < 2; ++bj) {
                    f32x4 x0, x1;
                    if (XIN16) { const u32x4 w = *(const u32x4*)(xo + bj * HALF); x0 = (f32x4){bflo(w[0]), bfhi(w[0]), bflo(w[1]), bfhi(w[1])}; x1 = (f32x4){bflo(w[2]), bfhi(w[2]), bflo(w[3]), bfhi(w[3])}; }
                    else { const float* xin = (r < NLAT ? xlat + (size_t)r * 1024 : xctx + (size_t)(r - NLAT) * 1024) + col0 + bj * HALF; x0 = *(const f32x4*)xin; x1 = *(const f32x4*)(xin + 4); }
                    x0 += gv[bj][0] * acc[ai][bj][m][0]; x1 += gv[bj][1] * acc[ai][bj][m][1];
                    u32x4 o; o[0] = pk2(x0[0], x0[1]); o[1] = pk2(x0[2], x0[3]); o[2] = pk2(x1[0], x1[1]); o[3] = pk2(x1[2], x1[3]);
                    *(u32x4*)(xo + bj * HALF) = o; }
            }
    }
};
struct EpiSwiglu {
    static constexpr bool PERM = true;
    unsigned char* ACT; const float* b1;
    DI void operator()(const f32x4 (&acc)[2][2][4][2], const Unit& u, int wr, int wc, int fr, int fq) const {
        const int row0 = u.orow0 + wr * 64 + fr, col0 = u.pn * HALF + wc * 32 + 8 * fq;
        const float* bg = b1 + (size_t)u.e * 2048 + col0; const float* bl = bg + 1024;
        const f32x4 bg0 = *(const f32x4*)bg, bg1 = *(const f32x4*)(bg + 4), bl0 = *(const f32x4*)bl, bl1 = *(const f32x4*)(bl + 4);
#pragma unroll
        for (int ai = 0; ai < 2; ++ai)
#pragma unroll
            for (int m = 0; m < 4; ++m) { const size_t r = (size_t)(row0 + ai * HALF + m * 16);
                u32x2 w;
#pragma unroll
                for (int n = 0; n < 2; ++n) {
                    const f32x4 seven = {7.0f, 7.0f, 7.0f, 7.0f};
                    const f32x4 xg = __builtin_elementwise_min(acc[ai][0][m][n] + (n ? bg1 : bg0), seven);
                    const f32x4 xl = __builtin_elementwise_min(__builtin_elementwise_max(acc[ai][1][m][n] + (n ? bl1 : bl0), -seven), seven);
                    const f32x4 ea = xg * (-1.702f * 1.4426950408889634f);
                    f32x4 d = {ex2(ea[0]), ex2(ea[1]), ex2(ea[2]), ex2(ea[3])}; d += 1.0f;
                    const f32x4 rc = {__builtin_amdgcn_rcpf(d[0]), __builtin_amdgcn_rcpf(d[1]), __builtin_amdgcn_rcpf(d[2]), __builtin_amdgcn_rcpf(d[3])};
                    const f32x4 o = (xg * rc) * (xl * 8.0f + 8.0f);
                    w[n] = pk4_fp8(o[0], o[1], o[2], o[3]); }
                *(u32x2*)(ACT + r * 1024 + col0) = w; }
    }
};
struct EpiY2 {
    static constexpr bool PERM = true;
    bf16_t* Y2; const float* b2;
    DI void operator()(const f32x4 (&acc)[2][2][4][2], const Unit& u, int wr, int wc, int fr, int fq) const {
        const int row0 = u.orow0 + wr * 64 + fr, col0 = u.pn * BM + wc * 32 + 8 * fq;
        f32x4 bv[2][2];
#pragma unroll
        for (int bj = 0; bj < 2; ++bj)
#pragma unroll
            for (int n = 0; n < 2; ++n) bv[bj][n] = *(const f32x4*)(b2 + (size_t)u.e * 1024 + col0 + bj * HALF + 4 * n);
#pragma unroll
        for (int ai = 0; ai < 2; ++ai)
#pragma unroll
            for (int m = 0; m < 4; ++m) {
#pragma unroll
                for (int bj = 0; bj < 2; ++bj) { const f32x4 v0 = (acc[ai][bj][m][0] + bv[bj][0]) * 16.0f, v1 = (acc[ai][bj][m][1] + bv[bj][1]) * 16.0f;
                    u32x2 w; w[0] = pk4_fp8(v0[0], v0[1], v0[2], v0[3]); w[1] = pk4_fp8(v1[0], v1[1], v1[2], v1[3]);
                    *(u32x2*)((unsigned char*)Y2 + (size_t)(row0 + ai * HALF + m * 16) * 1024 + col0 + bj * HALF) = w; } }
    }
};
struct EpiY2NoBias {
    static constexpr bool PERM = true;
    bf16_t* Y2;
    DI void operator()(const f32x4 (&acc)[2][2][4][2], const Unit& u, int wr, int wc, int fr, int fq) const {
        const int row0 = u.orow0 + wr * 64 + fr, col0 = u.pn * BM + wc * 32 + 8 * fq;
#pragma unroll
        for (int ai = 0; ai < 2; ++ai)
#pragma unroll
            for (int m = 0; m < 4; ++m) { bf16_t* rowp = Y2 + (size_t)(row0 + ai * HALF + m * 16) * 1024 + col0;
#pragma unroll
                for (int bj = 0; bj < 2; ++bj) { const f32x4 v0 = acc[ai][bj][m][0], v1 = acc[ai][bj][m][1];
                    u32x4 w; w[0] = pk2(v0[0], v0[1]); w[1] = pk2(v0[2], v0[3]); w[2] = pk2(v1[0], v1[1]); w[3] = pk2(v1[2], v1[3]);
                    *(u32x4*)(rowp + bj * HALF) = w; } }
    }
};
struct EpiSink {
    static constexpr bool PERM = true;
    DI void operator()(const f32x4 (&acc)[2][2][4][2], const Unit&, int, int, int, int) const {
#pragma unroll
        for (int ai = 0; ai < 2; ++ai)
#pragma unroll
            for (int bj = 0; bj < 2; ++bj)
#pragma unroll
                for (int m = 0; m < 4; ++m)
#pragma unroll
                    for (int n = 0; n < 2; ++n) asm volatile("" :: "v"(acc[ai][bj][m][n]));
    }
};
}

template <int WHICH>
DI void moe_gemm(const Args& a, LAS unsigned char* lds, int layer) {
    const int tid = threadIdx.x; unsigned char* ws = a.ws;
    LAS int* tile_e = (LAS int*)(lds + pg8::STAGE_BYTES); LAS int* tile_s0 = tile_e + 576; LAS int* misc = tile_s0 + 576; LAS int* rowtab = misc + 64;
    const int* etot = (const int*)(ws + WS_ETOT);
    if (tid < 32) misc[32 + tid] = (ld_i(etot + tid) + 255) >> 8;
    __syncthreads();
    if (tid < 32) { int pre = 0; for (int e2 = 0; e2 < tid; ++e2) pre += misc[32 + e2]; const int n = misc[32 + tid];
        for (int t = 0; t < n; ++t) { tile_e[pre + t] = tid; tile_s0[pre + t] = 256 * (pre + t); }
        if (tid == 31) misc[0] = pre + n; }
    __syncthreads();
    const int ntile = misc[0];
    constexpr int NPN = (WHICH == 1) ? 8 : 4;
    pg8::MoeOrder S; S.ntile = ntile; S.NPN = NPN; S.G = gridDim.x; S.c = blockIdx.x; S.tile_e = tile_e; S.tile_s0 = tile_s0; S.rowtab = rowtab; S.btile = 256u * 1024u;
    if (WHICH == 1) {
        const int* stok = (const int*)(ws + WS_STOK);
        { int nr = 0; for (;; ++nr) { int pn_; if (S.tile_of(nr, pn_) < 0) break; }
          for (int f = tid; f < nr * 256; f += NTHR) { int pn_; const int t = S.tile_of(f >> 8, pn_); rowtab[f] = ld_i(stok + 256 * t + (f & 255)); } }
        __syncthreads();
        S.W = ws + WS_W1 + (size_t)layer * 32 * 2048 * 1024; S.wexp = 2048u * 1024u;
        pg8::EpiSwiglu E{ws + WS_ACT, a.in[I_B1] + (size_t)layer * 32 * 2048};
        pg8::gemm_phase<true, true, 127, 121>(lds, ws + WS_H, 512, S, E);
    } else {
        S.W = ws + WS_W2 + (size_t)layer * 32 * 1024 * 1024; S.wexp = 1024u * 1024u;
        for (int i = 0;; ++i) { int pn_; const int t = S.tile_of(i, pn_); if (t < 0) break; const int s0 = tile_s0[t]; if (tid < 256) rowtab[i * 256 + tid] = s0 + tid; }
        __syncthreads();
        pg8::EpiY2 E{(bf16_t*)(ws + WS_Y2), a.in[I_B2] + (size_t)layer * 32 * 1024};
        pg8::gemm_phase<true, true, 124, 121>(lds, ws + WS_ACT, 512, S, E);
    }
    __syncthreads();
}

constexpr size_t WS_Y2B = WS_END;
template <int VAR>
DI void moe_gemm2_probe(const Args& a, LAS unsigned char* lds, int layer) {
    const int tid = threadIdx.x; unsigned char* ws = a.ws;
    LAS int* tile_e = (LAS int*)(lds + pg8::STAGE_BYTES); LAS int* tile_s0 = tile_e + 576; LAS int* misc = tile_s0 + 576; LAS int* rowtab = misc + 64;
    const int* etot = (const int*)(ws + WS_ETOT);
    if (tid < 32) misc[32 + tid] = (ld_i(etot + tid) + 255) >> 8;
    __syncthreads();
    if (tid < 32) { int pre = 0; for (int e2 = 0; e2 < tid; ++e2) pre += misc[32 + e2]; const int n = misc[32 + tid];
        for (int t = 0; t < n; ++t) { tile_e[pre + t] = tid; tile_s0[pre + t] = 256 * (pre + t); }
        if (tid == 31) misc[0] = pre + n; }
    __syncthreads();
    const int ntile = misc[0];
    constexpr int NPN = 4;
    pg8::MoeOrder S; S.ntile = ntile; S.NPN = NPN; S.G = gridDim.x; S.c = blockIdx.x; S.tile_e = tile_e; S.tile_s0 = tile_s0; S.rowtab = rowtab; S.btile = 256u * 1024u;
    S.W = ws + WS_W2 + (size_t)layer * 32 * 1024 * 1024; S.wexp = (VAR == 4 || VAR == 5) ? 0u : 1024u * 1024u;
    for (int i = 0;; ++i) { int pn_; const int t = S.tile_of(i, pn_); if (t < 0) break; const int s0 = tile_s0[t]; if (tid < 256) rowtab[i * 256 + tid] = (VAR == 3 || VAR == 5) ? tid : s0 + tid; }
    __syncthreads();
    if (VAR == 2) { pg8::EpiY2NoBias E{(bf16_t*)(ws + WS_Y2B)}; pg8::gemm_phase<true, true, 124, 121>(lds, ws + WS_ACT, 512, S, E); }
    else if (VAR == 6) { pg8::EpiSink E{}; pg8::gemm_phase<true, true, 124, 121>(lds, ws + WS_ACT, 512, S, E); }
    else if (VAR == 7) { pg8::EpiSink E{}; pg8::gemm_phase<true, true, 124, 121, 1>(lds, ws + WS_ACT, 512, S, E); }
    else if (VAR == 8) { pg8::EpiSink E{}; pg8::gemm_phase<true, true, 124, 121, 2>(lds, ws + WS_ACT, 512, S, E); }
    else { pg8::EpiY2 E{(bf16_t*)(ws + WS_Y2B), a.in[I_B2] + (size_t)layer * 32 * 1024}; pg8::gemm_phase<true, true, 124, 121>(lds, ws + WS_ACT, 512, S, E); }
    __syncthreads();
}

constexpr int S5_ROWB = 272;
constexpr int S5_WAVE_LDS = 32 * S5_ROWB + 4096;
template <bool OUT>
DI void s5_item_old(const Args& a, LAS unsigned char* wl, int b, int g, int mc, int lane) {
    unsigned char* ws = a.ws;
    const bf16_t* P = (const bf16_t*)(ws + WS_P);
    const int row0 = chunk_row0(b, mc);
    const int h = lane >> 5, cl = lane & 31;
    LAS unsigned char* ytmp = wl + 32 * S5_ROWB;
    const int i0 = 4 * (lane >> 4);
#pragma unroll 1
    for (int dr = 0; dr < 2; ++dr) {
        const f32x4 t = ((const f32x4*)(ws + WS_S5A))[(dr * 32 + g) * 64 + lane]; const float are = t[0], aim = t[1];
        bf16x8 BF[4], CF[4];
#pragma unroll
        for (int m = 0; m < 4; ++m) BF[m] = ((const bf16x8*)(ws + WS_S5BF))[((dr * 32 + g) * 4 + m) * 64 + lane];
        float sre = 0.f, sim = 0.f;
        if (OUT) {
#pragma unroll
            for (int ks = 0; ks < 4; ++ks) CF[ks] = ((const bf16x8*)(ws + WS_S5CF))[((dr * 32 + g) * 4 + ks) * 64 + lane];
            const f32x2 h0 = ((const f32x2*)(ws + WS_S5H))[((((size_t)b * 2 + dr) * 32 + g) * 130 + mc) * 64 + lane]; sre = h0[0]; sim = h0[1];
        }
#pragma unroll 1
        for (int jj = 0; jj < 4; ++jj) {
            const int sb = dr ? 3 - jj : jj;
            const bf16x8 uf = *(const bf16x8*)(P + (size_t)(row0 + 32 * sb + cl) * 2560 + 16 * g + 8 * h);
            u32x2 uwp[2] = {{0u, 0u}, {0u, 0u}};
            if (OUT && dr == 0) {
#pragma unroll
                for (int tq = 0; tq < 2; ++tq) uwp[tq] = *(const u32x2*)(P + (size_t)(row0 + 32 * sb + 16 * tq + (lane & 15)) * 2560 + 16 * g + i0);
            }
#pragma unroll
            for (int half = 0; half < 2; ++half) {
                const f32x16 dre = MFMA32(uf, BF[2 * half], zero16()), dim = MFMA32(uf, BF[2 * half + 1], zero16());
#pragma unroll
                for (int rr = 0; rr < 16; ++rr) *(LAS unsigned*)(wl + crow(rr, h) * S5_ROWB + (32 * half + cl) * 4) = pk2(dre[rr], dim[rr]);
            }
            LDS_WAIT();
            {
                const int tstep = dr ? -S5_ROWB : S5_ROWB;
                LAS unsigned char* p0 = wl + (dr ? 31 * S5_ROWB : 0) + lane * 4;
                unsigned bu[32];
#pragma unroll
                for (int tt = 0; tt < 32; ++tt) bu[tt] = *(LAS unsigned*)(p0 + tt * tstep);
#pragma unroll
                for (int tt = 0; tt < 32; ++tt) {
                    const float nre = are * sre - aim * sim + bflo(bu[tt]), nim = are * sim + aim * sre + bfhi(bu[tt]); sre = nre; sim = nim;
                    if (OUT) *(LAS unsigned*)(p0 + tt * tstep) = pk2(sre, sim);
                }
            }
            if (OUT) {
                LDS_WAIT();
#pragma unroll
                for (int tq = 0; tq < 2; ++tq) {
                    f32x4 y = {0.f, 0.f, 0.f, 0.f};
#pragma unroll
                    for (int ks = 0; ks < 4; ++ks) {
                        const bf16x8 bfr = *(const LAS bf16x8*)(wl + (16 * tq + (lane & 15)) * S5_ROWB + (32 * ks + 8 * (lane >> 4)) * 2);
                        y = MFMA16(CF[ks], bfr, y);
                    }
                    const int tok = 32 * sb + 16 * tq + (lane & 15);
                    const size_t r = (size_t)(row0 + tok);
                    LAS u32x2* yt = (LAS u32x2*)(ytmp + tok * 32 + i0 * 2);
                    if (dr == 0) {
                        const f32x4 dsk = *(const f32x4*)(a.in[I_S5D] + 16 * g + i0);
                        const u32x2 uw = uwp[tq];
                        u32x2 o; o[0] = pk2(y[0] + bflo(uw[0]) * dsk[0], y[1] + bfhi(uw[0]) * dsk[1]); o[1] = pk2(y[2] + bflo(uw[1]) * dsk[2], y[3] + bfhi(uw[1]) * dsk[3]);
                        *yt = o;
                    } else {
                        const u32x2 pw = *yt;
                        float yy[4] = {y[0] + bflo(pw[0]), y[1] + bfhi(pw[0]), y[2] + bflo(pw[1]), y[3] + bfhi(pw[1])};
#pragma unroll
                        for (int q = 0; q < 4; ++q) { const float x = yy[q], z = 0.7978845608f * (x + 0.044715f * x * x * x); yy[q] = x * __builtin_amdgcn_rcpf(1.0f + __expf(-2.0f * z)); }
                        u32x2 o; o[0] = pk2(yy[0], yy[1]); o[1] = pk2(yy[2], yy[3]);
                        *(u32x2*)((bf16_t*)(ws + WS_YG) + r * 512 + 16 * g + i0) = o;
                    }
                }
                LDS_WAIT();
            }
        }
        if (!OUT) ((f32x2*)(ws + WS_S5E))[((((size_t)b * 2 + dr) * 32 + g) * 130 + mc) * 64 + lane] = (f32x2){sre, sim};
    }
}


template <bool OUT, int DR>
DI void s5_dir(const Args& a, LAS unsigned char* wl, int b, int g, int mc, int lane) {
    unsigned char* ws = a.ws;
    const bf16_t* P = (const bf16_t*)(ws + WS_P);
    const int row0 = chunk_row0(b, mc);
    const int h = lane >> 5, cl = lane & 31;
    LAS unsigned char* ytmp = wl + 32 * S5_ROWB;
    const int i0 = 4 * (lane >> 4);
    const f32x4 t4 = ((const f32x4*)(ws + WS_S5A))[(DR * 32 + g) * 64 + lane]; const float are = t4[0], aim = t4[1];
    bf16x8 BF[4], CF[4];
#pragma unroll
    for (int m = 0; m < 4; ++m) BF[m] = ((const bf16x8*)(ws + WS_S5BF))[((DR * 32 + g) * 4 + m) * 64 + lane];
    float sre = 0.f, sim = 0.f;
    if (OUT) {
#pragma unroll
        for (int ks = 0; ks < 4; ++ks) CF[ks] = ((const bf16x8*)(ws + WS_S5CF))[((DR * 32 + g) * 4 + ks) * 64 + lane];
        const f32x2 h0 = ((const f32x2*)(ws + WS_S5H))[((((size_t)b * 2 + DR) * 32 + g) * 130 + mc) * 64 + lane]; sre = h0[0]; sim = h0[1];
    }
#pragma unroll 1
    for (int jj = 0; jj < 4; ++jj) {
        const int sb = DR ? 3 - jj : jj;
        const bf16x8 uf = *(const bf16x8*)(P + (size_t)(row0 + 32 * sb + cl) * 2560 + 16 * g + 8 * h);
        f32x16 xre = MFMA32(uf, BF[0], zero16()), xim = MFMA32(uf, BF[1], zero16()), yre = MFMA32(uf, BF[2], zero16()), yim = MFMA32(uf, BF[3], zero16());
        asm volatile("s_nop 15\n\ts_nop 15\n\ts_nop 15\n\ts_nop 15\n\ts_nop 15\n\ts_nop 15" : "+v"(xre), "+v"(xim), "+v"(yre), "+v"(yim));
#pragma unroll
        for (int rr = 0; rr < 16; ++rr) {
            const float xa = xre[rr], ya = yre[rr], xb = xim[rr], yb = yim[rr];
            auto r1 = __builtin_amdgcn_permlane32_swap(__float_as_uint(xa), __float_as_uint(ya), false, false);
            xre[rr] = __uint_as_float(r1[0]); yre[rr] = __uint_as_float(r1[1]);
            auto r2 = __builtin_amdgcn_permlane32_swap(__float_as_uint(xb), __float_as_uint(yb), false, false);
            xim[rr] = __uint_as_float(r2[0]); yim[rr] = __uint_as_float(r2[1]);
        }
#pragma unroll
        for (int tt = 0; tt < 32; ++tt) {
            const int tk = DR ? 31 - tt : tt, rr = (tk & 3) + 4 * (tk >> 3);
            const float bre = ((tk >> 2) & 1) ? yre[rr] : xre[rr], bim = ((tk >> 2) & 1) ? yim[rr] : xim[rr];
            const float nre = are * sre - aim * sim + bre, nim = are * sim + aim * sre + bim; sre = nre; sim = nim;
            if (OUT) *(LAS unsigned*)(wl + tk * S5_ROWB + lane * 4) = pk2(sre, sim);
        }
        if (OUT) {
            LDS_WAIT();
#pragma unroll
            for (int tq = 0; tq < 2; ++tq) {
                f32x4 y = {0.f, 0.f, 0.f, 0.f};
#pragma unroll
                for (int ks = 0; ks < 4; ++ks) {
                    const bf16x8 bfr = *(const LAS bf16x8*)(wl + (16 * tq + (lane & 15)) * S5_ROWB + (32 * ks + 8 * (lane >> 4)) * 2);
                    y = MFMA16(CF[ks], bfr, y);
                }
                const int tok = 32 * sb + 16 * tq + (lane & 15);
                const size_t r = (size_t)(row0 + tok);
                LAS u32x2* yt = (LAS u32x2*)(ytmp + tok * 32 + i0 * 2);
                if (DR == 0) {
                    const f32x4 dsk = *(const f32x4*)(a.in[I_S5D] + 16 * g + i0);
                    const u32x2 uw = *(const u32x2*)(P + r * 2560 + 16 * g + i0);
                    u32x2 o; o[0] = pk2(y[0] + bflo(uw[0]) * dsk[0], y[1] + bfhi(uw[0]) * dsk[1]); o[1] = pk2(y[2] + bflo(uw[1]) * dsk[2], y[3] + bfhi(uw[1]) * dsk[3]);
                    *yt = o;
                } else {
                    const u32x2 pw = *yt;
                    float yy[4] = {y[0] + bflo(pw[0]), y[1] + bfhi(pw[0]), y[2] + bflo(pw[1]), y[3] + bfhi(pw[1])};
#pragma unroll
                    for (int q = 0; q < 4; ++q) { const float x = yy[q], z = 0.7978845608f * (x + 0.044715f * x * x * x); yy[q] = x * __builtin_amdgcn_rcpf(1.0f + __expf(-2.0f * z)); }
                    u32x2 o; o[0] = pk2(yy[0], yy[1]); o[1] = pk2(yy[2], yy[3]);
                    *(u32x2*)((bf16_t*)(ws + WS_YG) + r * 512 + 16 * g + i0) = o;
                }
            }
            LDS_WAIT();
        }
    }
    if (!OUT) ((f32x2*)(ws + WS_S5E))[((((size_t)b * 2 + DR) * 32 + g) * 130 + mc) * 64 + lane] = (f32x2){sre, sim};
}
template <bool OUT>
DI void s5_item(const Args& a, LAS unsigned char* wl, int b, int g, int mc, int lane) {
    s5_dir<OUT, 0>(a, wl, b, g, mc, lane);
    asm volatile("" ::: "memory");
    s5_dir<OUT, 1>(a, wl, b, g, mc, lane);
}

DI void rope8(const u32x4& x1, const u32x4& x2, const f32x2* tab  , int f0, float sc, float* o1, float* o2) {
#pragma unroll
    for (int q = 0; q < 4; ++q) {
        const float a0 = bflo(x1[q]), a1 = bfhi(x1[q]), b0 = bflo(x2[q]), b1 = bfhi(x2[q]);
        if (tab) { const f32x2 c0 = tab[f0 + 2 * q], c1 = tab[f0 + 2 * q + 1];
            o1[2 * q] = (a0 * c0[0] - b0 * c0[1]) * sc; o2[2 * q] = (a0 * c0[1] + b0 * c0[0]) * sc;
            o1[2 * q + 1] = (a1 * c1[0] - b1 * c1[1]) * sc; o2[2 * q + 1] = (a1 * c1[1] + b1 * c1[0]) * sc;
        } else { o1[2 * q] = a0 * sc; o1[2 * q + 1] = a1 * sc; o2[2 * q] = b0 * sc; o2[2 * q + 1] = b1 * sc; }
    }
}
DI void rope8u(const u32x4& x1, const u32x4& x2, const f32x2* tab, int f0, float sc, float* o1, float* o2) {
    f32x4 cs[4];
#pragma unroll
    for (int q = 0; q < 4; ++q) cs[q] = *(const f32x4*)(tab + f0 + 2 * q);
#pragma unroll
    for (int q = 0; q < 4; ++q) {
        const float a0 = bflo(x1[q]), a1 = bfhi(x1[q]), b0 = bflo(x2[q]), b1 = bfhi(x2[q]);
        o1[2 * q] = (a0 * cs[q][0] - b0 * cs[q][1]) * sc; o2[2 * q] = (a0 * cs[q][1] + b0 * cs[q][0]) * sc;
        o1[2 * q + 1] = (a1 * cs[q][2] - b1 * cs[q][3]) * sc; o2[2 * q + 1] = (a1 * cs[q][3] + b1 * cs[q][2]) * sc;
    }
}
DI u32x4 pack8f(const float* o, float w) { u32x4 r; r[0] = pk2(o[0] * w, o[1] * w); r[1] = pk2(o[2] * w, o[3] * w); r[2] = pk2(o[4] * w, o[5] * w); r[3] = pk2(o[6] * w, o[7] * w); return r; }

template <int HI>
DI void tr_read4(unsigned base, bf16x8 (&f)[4]) {
    s16x4 r0, r1, r2, r3, r4, r5, r6, r7;
    asm volatile("ds_read_b64_tr_b16 %0, %8 offset:%9\n\tds_read_b64_tr_b16 %1, %8 offset:%10\n\tds_read_b64_tr_b16 %2, %8 offset:%11\n\tds_read_b64_tr_b16 %3, %8 offset:%12\n\t"
                 "ds_read_b64_tr_b16 %4, %8 offset:%13\n\tds_read_b64_tr_b16 %5, %8 offset:%14\n\tds_read_b64_tr_b16 %6, %8 offset:%15\n\tds_read_b64_tr_b16 %7, %8 offset:%16\n\ts_waitcnt lgkmcnt(0)"
                 : "=&v"(r0), "=&v"(r1), "=&v"(r2), "=&v"(r3), "=&v"(r4), "=&v"(r5), "=&v"(r6), "=&v"(r7)
                 : "v"(base), "i"(0), "i"(HI), "i"(64), "i"(HI + 64), "i"(128), "i"(HI + 128), "i"(192), "i"(HI + 192) : "memory");
    f[0] = __builtin_shufflevector(r0, r1, 0, 1, 2, 3, 4, 5, 6, 7); f[1] = __builtin_shufflevector(r2, r3, 0, 1, 2, 3, 4, 5, 6, 7);
    f[2] = __builtin_shufflevector(r4, r5, 0, 1, 2, 3, 4, 5, 6, 7); f[3] = __builtin_shufflevector(r6, r7, 0, 1, 2, 3, 4, 5, 6, 7);
}
struct R1Raw { u32x4 v[4], k1[2], k2[2]; };
DI void ret1_load(const Args& a, int q, R1Raw& raw) {
    const int tid = threadIdx.x; const bf16_t* P = (const bf16_t*)(a.ws + WS_P);
    const int b = q / 520, r = q % 520, hd = r / 130, mc = r % 130, row0 = chunk_row0(b, mc);
#pragma unroll
    for (int i = 0; i < 4; ++i) { const int c = tid + 512 * i, tok = c >> 4, ch = c & 15; raw.v[i] = *(const u32x4*)(P + (size_t)(row0 + tok) * 2560 + 1536 + 128 * hd + 8 * ch); }
#pragma unroll
    for (int i = 0; i < 2; ++i) { const int it = tid + 512 * i, tok = it >> 3, pr = it & 7, dk0 = (pr & 3) * 8 + (pr >> 2) * 64;
        const bf16_t* src = P + (size_t)(row0 + tok) * 2560 + 1024 + 128 * hd + dk0; raw.k1[i] = *(const u32x4*)src; raw.k2[i] = *(const u32x4*)(src + 32); }
}
DI void ret1_loop(const Args& a, LAS unsigned char* lds) {
    const int tid = threadIdx.x, lane = tid & 63, wave = tid >> 6;
    unsigned char* ws = a.ws;
    LAS unsigned char* Vl = lds; LAS unsigned char* Kf = lds + 32768; LAS unsigned char* Kb = lds + 65536;
    const int dvt = wave & 3, dir = wave >> 2;
    const int h = lane >> 5, i16 = lane & 15, qq = i16 >> 2, p = i16 & 3, blk = (lane >> 4) & 1;
    const unsigned vbase = (unsigned)(size_t)Vl, kbase = (unsigned)(size_t)(dir ? Kb : Kf);
    R1Raw raw;
    int q = blockIdx.x;
    if (q < 1040) ret1_load(a, q, raw);
#pragma unroll 1
    for (; q < 1040; q += gridDim.x) {
        const int b = q / 520, r = q % 520, hd = r / 130, mc = r % 130; const bool lat = mc < 128;
        const float lgf = a.in[I_DECAY][hd] * 1.4426950408889634f, lgb = a.in[I_DECAY][4 + hd] * 1.4426950408889634f;
        __syncthreads();
#pragma unroll
        for (int i = 0; i < 4; ++i) { const int c = tid + 512 * i, tok = c >> 4, ch = c & 15; *(LAS u32x4*)(Vl + tok * 256 + ch * 16) = raw.v[i]; }
#pragma unroll
        for (int i = 0; i < 2; ++i) { const int it = tid + 512 * i, tok = it >> 3, pr = it & 7, dk0 = (pr & 3) * 8 + (pr >> 2) * 64;
            const int t = mc * 128 + tok, pos = (pr >> 2) ? (t & 63) : (t >> 6);
            const f32x2* tab = lat ? (const f32x2*)(ws + WS_ROPE) + pos * 32 : nullptr;
            float o1[8], o2[8]; rope8(raw.k1[i], raw.k2[i], tab, (pr & 3) * 8, 0.08838834764831845f, o1, o2);
            const float wf = ex2(lgf * (float)(127 - tok)), wb = ex2(lgb * (float)tok);
            *(LAS u32x4*)(Kf + tok * 256 + dk0 * 2) = pack8f(o1, wf); *(LAS u32x4*)(Kf + tok * 256 + (dk0 + 32) * 2) = pack8f(o2, wf);
            *(LAS u32x4*)(Kb + tok * 256 + dk0 * 2) = pack8f(o1, wb); *(LAS u32x4*)(Kb + tok * 256 + (dk0 + 32) * 2) = pack8f(o2, wb); }
        __syncthreads();
        if (q + (int)gridDim.x < 1040) ret1_load(a, q + gridDim.x, raw);
        f32x16 acc[4];
#pragma unroll
        for (int i = 0; i < 4; ++i) acc[i] = zero16();
#pragma unroll 2
        for (int ks = 0; ks < 8; ++ks) {
            const unsigned rlo = (unsigned)(16 * ks + 8 * h + qq) * 256u, rhi = rlo + 4u * 256u, cofs = (unsigned)(16 * blk + 4 * p) * 2u;
            const bf16x8 af = tr_read2(vbase + rlo + 64u * dvt + cofs, vbase + rhi + 64u * dvt + cofs);
            bf16x8 bfv[4]; tr_read4<1024>(kbase + rlo + cofs, bfv);
#pragma unroll
            for (int dkt = 0; dkt < 4; ++dkt) acc[dkt] = MFMA32(af, bfv[dkt], acc[dkt]);
        }
        unsigned* out = (unsigned*)(ws + WS_KVL) + ((((size_t)b * 4 + hd) * 2 + dir) * 130 + mc) * 8192;
#pragma unroll
        for (int dkt = 0; dkt < 4; ++dkt)
#pragma unroll
            for (int rr = 0; rr < 16; rr += 2) out[(size_t)((32 * dvt + crow(rr, h)) >> 1) * 128 + 32 * dkt + (lane & 31)] = pk2(acc[dkt][rr], acc[dkt][rr + 1]);
    }
    __syncthreads();
}

DI void ret3_stage(const Args& a, LAS unsigned char* li, int b, int hd, int mc, int lt) {
    unsigned char* ws = a.ws; const bf16_t* P = (const bf16_t*)(ws + WS_P);
    const int row0 = chunk_row0(b, mc); const bool lat = mc < 128;
#pragma unroll
    for (int i = 0; i < 8; ++i) { const int c = lt + 256 * i, tok = c >> 4, ch = c & 15;
        *(LAS u32x4*)(li + 32768 + tok * 256 + ch * 16) = *(const u32x4*)(P + (size_t)(row0 + tok) * 2560 + 1536 + 128 * hd + 8 * ch); }
#pragma unroll
    for (int i = 0; i < 4; ++i) { const int it = lt + 256 * i, tok = it >> 3, pr = it & 7, dk0 = (pr & 3) * 8 + (pr >> 2) * 64;
        const bf16_t* src = P + (size_t)(row0 + tok) * 2560 + 1024 + 128 * hd + dk0;
        const u32x4 x1 = *(const u32x4*)src, x2 = *(const u32x4*)(src + 32);
        const int t = mc * 128 + tok, pos = (pr >> 2) ? (t & 63) : (t >> 6);
        const f32x2* tab = (const f32x2*)(ws + WS_ROPE) + (lat ? pos : 0) * 32;
        float o1[8], o2[8]; rope8u(x1, x2, tab, (pr & 3) * 8, 0.08838834764831845f, o1, o2);
        *(LAS u32x4*)(li + tok * 256 + dk0 * 2) = pack8f(o1, 1.0f); *(LAS u32x4*)(li + tok * 256 + (dk0 + 32) * 2) = pack8f(o2, 1.0f); }
}
DI void ret3_compute(const Args& a, LAS unsigned char* li, int b, int hd, int mc, int wi, int lane) {
    unsigned char* ws = a.ws; const bf16_t* P = (const bf16_t*)(ws + WS_P);
    const int row0 = chunk_row0(b, mc); const bool lat = mc < 128;
    const int h = lane >> 5, cl = lane & 31, iq = 32 * wi + cl;
    const float lgf = a.in[I_DECAY][hd] * 1.4426950408889634f, lgb = a.in[I_DECAY][4 + hd] * 1.4426950408889634f;
    bf16x8 Qf[8];
    {
        const bf16_t* src = P + (size_t)(row0 + iq) * 2560 + 512 + 128 * hd + 8 * h;
        u32x4 raw[8];
#pragma unroll
        for (int s = 0; s < 8; ++s) raw[s] = *(const u32x4*)(src + 16 * s);
        const int t = mc * 128 + iq;
#pragma unroll
        for (int grp = 0; grp < 2; ++grp)
#pragma unroll
            for (int s1 = 0; s1 < 2; ++s1) { const int s = 4 * grp + s1; const int pos = grp ? (t & 63) : (t >> 6);
                const f32x2* tab = lat ? (const f32x2*)(ws + WS_ROPE) + pos * 32 : nullptr;
                float o1[8], o2[8]; rope8(raw[s], raw[s + 2], tab, 16 * s1 + 8 * h, 1.0f, o1, o2);
                Qf[s] = __builtin_bit_cast(bf16x8, pack8f(o1, 1.0f)); Qf[s + 2] = __builtin_bit_cast(bf16x8, pack8f(o2, 1.0f)); }
    }
    f32x16 O[4];
    {
        const bf16_t* Sin0 = (const bf16_t*)(ws + WS_SIN) + ((((size_t)b * 4 + hd) * 2 + 0) * 130 + mc) * 16384 + (size_t)cl * 128 + 8 * h;
        const float wqf = ex2(lgf * (float)(iq + 1)), wqb = ex2(lgb * (float)(128 - iq));
        bf16x8 af[2][8];
#pragma unroll
        for (int s = 0; s < 8; ++s) af[0][s] = *(const bf16x8*)(Sin0 + 16 * s);
#pragma unroll
        for (int g = 0; g < 8; ++g) {
            const int dir = g >> 2, dvt = g & 3;
            if (g + 1 < 8) { const int dir1 = (g + 1) >> 2, dvt1 = (g + 1) & 3; const bf16_t* nx = Sin0 + (size_t)dir1 * 130 * 16384 + (size_t)(32 * dvt1) * 128;
#pragma unroll
                for (int s = 0; s < 8; ++s) af[(g + 1) & 1][s] = *(const bf16x8*)(nx + 16 * s); }
            f32x16 d = zero16();
#pragma unroll
            for (int s = 0; s < 8; ++s) d = MFMA32(af[g & 1][s], Qf[s], d);
            if (dir == 0) O[dvt] = d * wqf; else O[dvt] += d * wqb;
            asm volatile("" ::: "memory");
        }
    }
    const int i16 = lane & 15, q4 = i16 >> 2, p4 = i16 & 3, blk = (lane >> 4) & 1;
    const unsigned vbase = (unsigned)(size_t)(li + 32768);
#pragma unroll 1
    for (int jt = 0; jt < 4; ++jt) {
        f32x16 st = zero16();
#pragma unroll
        for (int s = 0; s < 8; ++s) { const bf16x8 kf = *(const LAS bf16x8*)(li + (32 * jt + cl) * 256 + (16 * s + 8 * h) * 2); st = MFMA32(kf, Qf[s], st); }
#pragma unroll
        for (int rr = 0; rr < 16; ++rr) { const int j = 32 * jt + crow(rr, h), d = iq - j;
            const float fd = (float)d; const float w = ex2(d > 0 ? lgf * fd : -lgb * fd) + (d == 0 ? 1.0f : 0.0f); st[rr] *= w; }
#pragma unroll
        for (int s2 = 0; s2 < 2; ++s2) {
            const bf16x8 pf = pack8(st, s2);
            const unsigned rlo = (unsigned)(32 * jt + 16 * s2 + 4 * h + q4) * 256u, rhi = rlo + 8u * 256u, cofs = (unsigned)(16 * blk + 4 * p4) * 2u;
            bf16x8 vf[4]; tr_read4<2048>(vbase + rlo + cofs, vf); (void)rhi;
#pragma unroll
            for (int dvt = 0; dvt < 4; ++dvt) O[dvt] = MFMA32(vf[dvt], pf, O[dvt]);
        }
        asm volatile("" ::: "memory");
    }
    float ss = 0.f;
#pragma unroll
    for (int dvt = 0; dvt < 4; ++dvt)
#pragma unroll
        for (int rr = 0; rr < 16; ++rr) ss += O[dvt][rr] * O[dvt][rr];
    ss += __shfl_xor(ss, 32);
    const float rstd = 1.0f / sqrtf(ss * (1.0f / 128.0f) + 1e-6f);
    const size_t r = (size_t)(row0 + iq);
    bf16_t* AR = (bf16_t*)(ws + WS_AR);
#pragma unroll
    for (int dvt = 0; dvt < 4; ++dvt)
#pragma unroll
        for (int g4 = 0; g4 < 4; ++g4) { const int dv = 32 * dvt + 8 * g4 + 4 * h;
            const u32x2 gw = *(const u32x2*)(P + r * 2560 + 2048 + 128 * hd + dv);
            float gv[4] = {bflo(gw[0]), bfhi(gw[0]), bflo(gw[1]), bfhi(gw[1])}, o[4];
#pragma unroll
            for (int e = 0; e < 4; ++e) o[e] = O[dvt][4 * g4 + e] * rstd * (gv[e] * sigmoidf_(gv[e]));
            u32x2 w; w[0] = pk2(o[0], o[1]); w[1] = pk2(o[2], o[3]);
            *(u32x2*)(AR + r * 1024 + 512 + 128 * hd + dv) = w; }
}

DI int scan_mc(int dr, int sc) { return dr == 0 ? (sc < 2 ? 128 + sc : sc - 2) : (sc < 2 ? 129 - sc : 129 - sc); }

DI void scan_pass1(const Args& a, LAS unsigned char* lds) {
    const int tid = threadIdx.x, lane = tid & 63, wave = tid >> 6;
    for (int it = (int)blockIdx.x - 16; it < 1040; it += (int)gridDim.x - 16) {
        if (it < 0) break;
        const int b = it / 520, q = it % 520, mc = q / 4, g = (q % 4) * 8 + wave; s5_item<false>(a, lds + wave * S5_WAVE_LDS, b, g, mc, lane); }
    __syncthreads();
    ret1_loop(a, lds);
}
DI void scan_pass2(const Args& a) {
    const int tid = threadIdx.x, lane = tid & 63, wave = tid >> 6; unsigned char* ws = a.ws;
    if (blockIdx.x < 128 && wave == 0) {
        const int ch = blockIdx.x, b = ch >> 6, dr = (ch >> 5) & 1, g = ch & 31;
        const f32x4 t = ((const f32x4*)(ws + WS_S5A))[(dr * 32 + g) * 64 + lane]; const float pr = t[2], pi = t[3];
        const f32x2* E = (const f32x2*)(ws + WS_S5E) + (((size_t)b * 2 + dr) * 32 + g) * 130 * 64 + lane; f32x2* Hn = (f32x2*)(ws + WS_S5H) + (((size_t)b * 2 + dr) * 32 + g) * 130 * 64 + lane;
        float hr = 0.f, hi = 0.f;
        for (int s0 = 0; s0 < 130; s0 += 10) {
            f32x2 e[10];
#pragma unroll
            for (int k = 0; k < 10; ++k) e[k] = E[(size_t)scan_mc(dr, s0 + k) * 64];
#pragma unroll
            for (int k = 0; k < 10; ++k) { Hn[(size_t)scan_mc(dr, s0 + k) * 64] = (f32x2){hr, hi}; const float nr = pr * hr - pi * hi + e[k][0], ni = pr * hi + pi * hr + e[k][1]; hr = nr; hi = ni; }
        }
    }
    const int gt = blockIdx.x * NTHR + tid;
    for (int id = gt; id < 16 * 8192; id += gridDim.x * NTHR) {
        const int chn = id >> 13, pe = id & 8191, dvp = pe >> 7, dk = pe & 127, dr = chn & 1, hd = (chn >> 1) & 3;
        const float g128 = __expf(a.in[I_DECAY][dr * 4 + hd] * 128.0f);
        const unsigned* KV = (const unsigned*)(ws + WS_KVL) + (size_t)chn * 130 * 8192 + pe; bf16_t* Sn = (bf16_t*)(ws + WS_SIN) + (size_t)chn * 130 * 16384 + (2 * dvp) * 128 + dk;
        float s0v = 0.f, s1v = 0.f;
        for (int c0 = 0; c0 < 130; c0 += 10) {
            unsigned kv[10];
#pragma unroll
            for (int k = 0; k < 10; ++k) kv[k] = KV[(size_t)scan_mc(dr, c0 + k) * 8192];
#pragma unroll
            for (int k = 0; k < 10; ++k) { const unsigned w = pk2(s0v, s1v); bf16_t* o = Sn + (size_t)scan_mc(dr, c0 + k) * 16384; o[0] = (bf16_t)(w & 0xffffu); o[128] = (bf16_t)(w >> 16);
                s0v = g128 * s0v + bflo(kv[k]); s1v = g128 * s1v + bfhi(kv[k]); }
        }
    }
}
DI void scan_pass3(const Args& a, LAS unsigned char* lds) {
    const int tid = threadIdx.x, lane = tid & 63, wave = tid >> 6;
    for (int it = (int)blockIdx.x - 8; it < 1040; it += (int)gridDim.x - 8) {
        if (it < 0) break;
        const int b = it / 520, q = it % 520, mc = q / 4, g = (q % 4) * 8 + wave; s5_item_old<true>(a, lds + wave * S5_WAVE_LDS, b, g, mc, lane); }
    for (int p = blockIdx.x; p < 520; p += gridDim.x) { const int q = 2 * p + (wave >> 2), b = q / 520, r = q % 520, hd = r / 130, mc = r % 130;
        LAS unsigned char* li = lds + (wave >> 2) * 65536;
        __syncthreads(); ret3_stage(a, li, b, hd, mc, tid & 255); __syncthreads(); ret3_compute(a, li, b, hd, mc, wave & 3, lane); }
    __syncthreads();
}

template <int STRIDE>
DI void tr_read8(unsigned base, bf16x8 (&f)[2][2]) {
    s16x4 r0, r1, r2, r3, r4, r5, r6, r7;
    asm volatile("ds_read_b64_tr_b16 %0, %8 offset:%9\n\tds_read_b64_tr_b16 %1, %8 offset:%10\n\tds_read_b64_tr_b16 %2, %8 offset:%11\n\tds_read_b64_tr_b16 %3, %8 offset:%12\n\t"
                 "ds_read_b64_tr_b16 %4, %8 offset:%13\n\tds_read_b64_tr_b16 %5, %8 offset:%14\n\tds_read_b64_tr_b16 %6, %8 offset:%15\n\tds_read_b64_tr_b16 %7, %8 offset:%16\n\ts_waitcnt lgkmcnt(0)"
                 : "=&v"(r0), "=&v"(r1), "=&v"(r2), "=&v"(r3), "=&v"(r4), "=&v"(r5), "=&v"(r6), "=&v"(r7)
                 : "v"(base), "i"(0), "i"(8 * STRIDE), "i"(64), "i"(8 * STRIDE + 64), "i"(16 * STRIDE), "i"(24 * STRIDE), "i"(16 * STRIDE + 64), "i"(24 * STRIDE + 64) : "memory");
    f[0][0] = __builtin_shufflevector(r0, r1, 0, 1, 2, 3, 4, 5, 6, 7); f[0][1] = __builtin_shufflevector(r2, r3, 0, 1, 2, 3, 4, 5, 6, 7);
    f[1][0] = __builtin_shufflevector(r4, r5, 0, 1, 2, 3, 4, 5, 6, 7); f[1][1] = __builtin_shufflevector(r6, r7, 0, 1, 2, 3, 4, 5, 6, 7);
}
constexpr int NA_ST = 144;
DI void na_phase(const Args& a, LAS unsigned char* lds) {
    int tid = threadIdx.x; asm volatile("" : "+v"(tid));
    const int lane = tid & 63, wave = tid >> 6; unsigned char* ws = a.ws;
    const bf16_t* QKV = (const bf16_t*)(ws + WS_P);
    bf16_t* AR = (bf16_t*)(ws + WS_AR);
    LAS unsigned char* cK = lds; LAS unsigned char* cV = lds + 256 * NA_ST;
    LAS unsigned char* vl = lds + 2 * 256 * NA_ST + wave * (32 * NA_ST);
    LAS float* rpbl = (LAS float*)(lds + 2 * 256 * NA_ST + 8 * 32 * NA_ST);
    LAS unsigned char* kl = lds + 114688 + wave * (32 * NA_ST);
    const int h = lane >> 5, cl = lane & 31, i16 = lane & 15, q4 = i16 >> 2, p4 = i16 & 3, blk = (lane >> 4) & 1;
    const float L2E = 1.4426950408889634f;
    const int c = blockIdx.x, b = c >> 7, hd = (c >> 3) & 15;
#pragma unroll
    for (int i = 0; i < 8; ++i) { const int ch = tid + 512 * i, which = ch >> 11, key = (ch >> 3) & 255, cc = ch & 7;
        const u32x4 v = *(const u32x4*)(QKV + (size_t)(NLAT + b * CTXL + key) * 3072 + (which ? 2048 : 1024) + 64 * hd + 8 * cc);
        *(LAS u32x4*)((which ? cV : cK) + key * NA_ST + cc * 16) = v; }
    for (int i = tid; i < 15 * 31; i += NTHR) rpbl[i] = a.in[I_RPB][hd * 465 + i] * L2E;
    __syncthreads();
    const unsigned vtr = (unsigned)(size_t)vl + (unsigned)((4 * h + q4) * NA_ST + (16 * blk + 4 * p4) * 2);
    const unsigned ctr = (unsigned)(size_t)cV + (unsigned)((4 * h + q4) * NA_ST + (16 * blk + 4 * p4) * 2);
#pragma unroll 1
    for (int j = 0; j < 8; ++j) {
        const int r = (c & 7) * 32 + 4 * j + (wave >> 1), qt = wave & 1;
        const int rs = min(max(r - 4, 0), 248), cb = qt ? 24 : 0;
        const int cq = 32 * qt + cl, cs = min(max(cq - 8, 0), 48);
        const size_t qrow = (size_t)b * SEQ + r * 64 + cq;
        bf16x8 Qf[4];
        {
            const size_t qrow0 = qrow - cl;
#pragma unroll
            for (int ii = 0; ii < 4; ++ii) { const int cc = lane + 64 * ii; const u32x4 qv = *(const u32x4*)(QKV + (qrow0 + (cc >> 3)) * 3072 + 64 * hd + 8 * (cc & 7)); *(LAS u32x4*)(kl + (cc >> 3) * NA_ST + (cc & 7) * 16) = qv; }
#pragma unroll
            for (int s = 0; s < 4; ++s) Qf[s] = *(const LAS bf16x8*)(kl + cl * NA_ST + (16 * s + 8 * h) * 2);
            LDS_WAIT();
        }
        float m_run = -1e30f, l_run = 0.f; f32x16 O[2] = {zero16(), zero16()};
        const bf16_t* kvb = QKV + ((size_t)b * SEQ + rs * 64 + cb) * 3072 + 64 * hd;
        const int koff0 = ((cl & 7) * 64 + (cl >> 3)) * 3072 + 1024 + 8 * h;
        int voff0[4];
#pragma unroll
        for (int ii = 0; ii < 4; ++ii) { const int cc = lane + 64 * ii, key = cc >> 3, ch = cc & 7; voff0[ii] = ((key & 7) * 64 + (key >> 3)) * 3072 + 2048 + 8 * ch; }
        int rowb[4];
#pragma unroll
        for (int q = 0; q < 4; ++q) rowb[q] = (rs + q + 4 * h - r + 7) * 31;
        u32x4 Kn[4], Vn[4];
#pragma unroll
        for (int ii = 0; ii < 4; ++ii) Kn[ii] = *(const u32x4*)(kvb + voff0[ii] - 1024);
#pragma unroll
        for (int ii = 0; ii < 4; ++ii) Vn[ii] = *(const u32x4*)(kvb + voff0[ii]);
#pragma unroll 1
        for (int kt = 0; kt < 10; ++kt) {
#pragma unroll
            for (int ii = 0; ii < 4; ++ii) { const int cc = lane + 64 * ii; *(LAS u32x4*)(kl + (cc >> 3) * NA_ST + (cc & 7) * 16) = Kn[ii]; *(LAS u32x4*)(vl + (cc >> 3) * NA_ST + (cc & 7) * 16) = Vn[ii]; }
            if (kt < 9) { const bf16_t* nb = kvb + (size_t)(kt + 1) * 4 * 3072;
#pragma unroll
                for (int ii = 0; ii < 4; ++ii) Kn[ii] = *(const u32x4*)(nb + voff0[ii] - 1024);
#pragma unroll
                for (int ii = 0; ii < 4; ++ii) Vn[ii] = *(const u32x4*)(nb + voff0[ii]); }
            f32x16 st = zero16();
#pragma unroll
            for (int s = 0; s < 4; ++s) { const bf16x8 kf = *(const LAS bf16x8*)(kl + cl * NA_ST + (16 * s + 8 * h) * 2); st = MFMA32(kf, Qf[s], st); }
            bf16x8 vf[2][2]; tr_read8<NA_ST>(vtr, vf);
            float mx = -1e30f;
            float bias[16];
#pragma unroll
            for (int g = 0; g < 4; ++g) { const int co = min(max(cb + 4 * kt + g - cq + 15, 0), 30);
#pragma unroll
                for (int q = 0; q < 4; ++q) bias[4 * g + q] = rpbl[rowb[q] + co]; }
#pragma unroll
            for (int rr = 0; rr < 16; ++rr) asm volatile("" : "+v"(bias[rr]));
#pragma unroll
            for (int g = 0; g < 4; ++g) {
                const int kcol = cb + 4 * kt + g; const bool valid = (kcol >= cs) && (kcol < cs + 16);
#pragma unroll
                for (int q = 0; q < 4; ++q) { const int rr = 4 * g + q;
                    const float sv = valid ? st[rr] * (0.125f * L2E) + bias[rr] : -INFINITY;
                    st[rr] = sv; mx = fmaxf(mx, sv); }
            }
            mx = fmaxf(mx, __shfl_xor(mx, 32));
            const float mnew = fmaxf(m_run, mx), alpha = ex2(m_run - mnew);
            float ls = 0.f;
#pragma unroll
            for (int rr = 0; rr < 16; ++rr) { const float pv = ex2(st[rr] - mnew); st[rr] = pv; ls += pv; }
            l_run = l_run * alpha + ls; m_run = mnew;
            if (!__all(alpha == 1.0f)) { O[0] *= alpha; O[1] *= alpha; }
#pragma unroll
            for (int s2 = 0; s2 < 2; ++s2) { const bf16x8 pf = pack8(st, s2); O[0] = MFMA32(vf[s2][0], pf, O[0]); O[1] = MFMA32(vf[s2][1], pf, O[1]); }
        }
#pragma unroll 1
        for (int kt = 0; kt < 8; ++kt) {
            f32x16 st = zero16();
#pragma unroll
            for (int s = 0; s < 4; ++s) { const bf16x8 kf = *(const LAS bf16x8*)(cK + (32 * kt + cl) * NA_ST + (16 * s + 8 * h) * 2); st = MFMA32(kf, Qf[s], st); }
            bf16x8 vf[2][2]; tr_read8<NA_ST>(ctr + (unsigned)(32 * kt * NA_ST), vf);
            float mx = -1e30f;
#pragma unroll
            for (int rr = 0; rr < 16; ++rr) mx = fmaxf(mx, st[rr]);
            mx = fmaxf(mx, __shfl_xor(mx, 32)) * (0.125f * L2E);
            const float mnew = fmaxf(m_run, mx), alpha = ex2(m_run - mnew);
            float ls = 0.f;
#pragma unroll
            for (int rr = 0; rr < 16; ++rr) { const float pv = ex2(st[rr] * (0.125f * L2E) - mnew); st[rr] = pv; ls += pv; }
            l_run = l_run * alpha + ls; m_run = mnew;
            if (!__all(alpha == 1.0f)) { O[0] *= alpha; O[1] *= alpha; }
#pragma unroll
            for (int s2 = 0; s2 < 2; ++s2) { const bf16x8 pf = pack8(st, s2); O[0] = MFMA32(vf[s2][0], pf, O[0]); O[1] = MFMA32(vf[s2][1], pf, O[1]); }
        }
        const float inv8 = 8.0f / (l_run + __shfl_xor(l_run, 32));
        u32x4 f0, f1;
#pragma unroll
        for (int g4 = 0; g4 < 4; ++g4) {
            const unsigned x = pk4_fp8(O[0][4 * g4] * inv8, O[0][4 * g4 + 1] * inv8, O[0][4 * g4 + 2] * inv8, O[0][4 * g4 + 3] * inv8);
            const unsigned y = pk4_fp8(O[1][4 * g4] * inv8, O[1][4 * g4 + 1] * inv8, O[1][4 * g4 + 2] * inv8, O[1][4 * g4 + 3] * inv8);
            auto r = __builtin_amdgcn_permlane32_swap(x, y, false, false);
            const unsigned a0 = r[0], a1 = r[1];
            if (g4 < 2) { f0[2 * g4] = a0; f0[2 * g4 + 1] = a1; } else { f1[2 * (g4 - 2)] = a0; f1[2 * (g4 - 2) + 1] = a1; }
        }
        { unsigned char* op = (unsigned char*)AR + qrow * 1024 + 64 * hd + 32 * h; *(u32x4*)op = f0; *(u32x4*)(op + 16) = f1; }
    }
    __syncthreads();
}

constexpr int NPH = 21;
__global__ void __launch_bounds__(NTHR, 2) mega(Args a) {
    extern __shared__ __attribute__((aligned(16))) unsigned char lds_raw[];
    LAS unsigned char* lds = (LAS unsigned char*)lds_raw;
    unsigned char* ws = a.ws;
    volatile LAS unsigned* ctlw = (volatile LAS unsigned*)(lds + LDS_CTL_OFF);
    if (threadIdx.x < 64) ctlw[threadIdx.x] = 0u;
    __syncthreads();
    const bool multi = (a.ph_hi - a.ph_lo) > 1;
    XcdBarrier bar; bar.bar = (unsigned*)(ws + WS_CTL); bar.x = 0; bar.st = ctlw;
    if (multi) bar = xcd_barrier_post((unsigned*)(ws + WS_CTL), ctlw);
    const int lo = a.ph_lo, hi = a.ph_hi;
#ifndef PH_MASK
#define PH_MASK 0x1fffff
#endif
#define IN(k) (((PH_MASK >> (k)) & 1) && lo <= (k) && (k) < hi)
#define SEAM(k) do { if (IN((k) + 1)) xcd_barrier(bar); } while (0)
#ifndef PROBE_DUP
#define PROBE_DUP 0
#endif
    const int G = gridDim.x, c = blockIdx.x;
    if (IN(0)) { p0_prologue(a, lds);
        if ((PROBE_DUP >> 0) & 1) { xcd_barrier(bar); { p0_prologue(a, lds); } }
        SEAM(0); }
    if (IN(1)) { row_phase<0>(a, lds, 0, NROW);
        if ((PROBE_DUP >> 1) & 1) { xcd_barrier(bar); { row_phase<0>(a, lds, 0, NROW); } }
        SEAM(1); }
    if (IN(2)) { pg8::DenseOrder S; S.init(NROW, 2560, 512, ws + WS_WIN, G, c); S.fill_rowtab((LAS int*)(lds + pg8::STAGE_BYTES)); pg8::EpiBf16 E{(bf16_t*)(ws + WS_P), 2560}; pg8::gemm_phase<true, true, 127, 121>(lds, ws + WS_H, 512, S, E); __syncthreads();
        if ((PROBE_DUP >> 2) & 1) { xcd_barrier(bar); { pg8::DenseOrder S; S.init(NROW, 2560, 1024, ws + WS_WIN, G, c); pg8::EpiBf16 E{(bf16_t*)(ws + WS_P), 2560}; pg8::gemm_phase<false, false, 127, 127>(lds, ws + WS_H, 1024, S, E); } }
        SEAM(2); }
    if (IN(3)) { scan_pass1(a, lds);
        if ((PROBE_DUP >> 3) & 1) { xcd_barrier(bar); { scan_pass1(a, lds); } }
        SEAM(3); }
    if (IN(4)) { scan_pass2(a);
        if ((PROBE_DUP >> 4) & 1) { xcd_barrier(bar); { scan_pass2(a); } }
        SEAM(4); }
    if (IN(5)) { scan_pass3(a, lds);
        if ((PROBE_DUP >> 5) & 1) { xcd_barrier(bar); { scan_pass3(a, lds); } }
        SEAM(5); }
    if (IN(6)) { pg8::DenseOrder S; S.init(NROW, 512, 512, ws + WS_WGLU, G, c); pg8::EpiGlu E{(const bf16_t*)(ws + WS_YG), (bf16_t*)(ws + WS_AR)}; pg8::gemm_phase<false, false, 127, 127>(lds, ws + WS_YG, 512, S, E);
        if ((PROBE_DUP >> 6) & 1) { xcd_barrier(bar); { pg8::DenseOrder S; S.init(NROW, 512, 512, ws + WS_WGLU, G, c); pg8::EpiGlu E{(const bf16_t*)(ws + WS_YG), (bf16_t*)(ws + WS_AR)}; pg8::gemm_phase<false, false, 127, 127>(lds, ws + WS_YG, 512, S, E); } }
        SEAM(6); }
    if (IN(7)) { pg8::DenseOrder S; S.init(NROW, 1024, 1024, ws + WS_WOUT, G, c);
        pg8::EpiResid<false> E{a.in[I_X], a.in[I_CTX], (bf16_t*)(ws + WS_XS), (const float*)(ws + WS_MODF) + 2 * 1024}; pg8::gemm_phase<false, false, 127, 127>(lds, ws + WS_AR, 1024, S, E);
        if ((PROBE_DUP >> 7) & 1) { xcd_barrier(bar); { pg8::DenseOrder S; S.init(NROW, 1024, 1024, ws + WS_WOUT, G, c);
        pg8::EpiResid<false> E{a.in[I_X], a.in[I_CTX], (bf16_t*)(ws + WS_XS), (const float*)(ws + WS_MODF) + 2 * 1024}; pg8::gemm_phase<false, false, 127, 127>(lds, ws + WS_AR, 1024, S, E); } }
        SEAM(7); }
    if (IN(8)) { router_phase(a, lds, 0, NROW);
        if ((PROBE_DUP >> 8) & 1) { xcd_barrier(bar); { router_phase(a, lds, 0, NROW); } }
        SEAM(8); }
    if (IN(9)) { slots_phase(a, lds, NROW);
        if ((PROBE_DUP >> 9) & 1) { xcd_barrier(bar); { slots_phase(a, lds, NROW); } }
        SEAM(9); }
    if (IN(10)) { moe_gemm<1>(a, lds, 0);
        if ((PROBE_DUP >> 10) & 1) { xcd_barrier(bar); { moe_gemm<1>(a, lds, 0); } }
        SEAM(10); }
#ifndef PROBE_G2
#define PROBE_G2 0
#endif
    if (IN(11)) { moe_gemm<2>(a, lds, 0);
        if (PROBE_G2) { xcd_barrier(bar); moe_gemm2_probe<PROBE_G2>(a, lds, 0); }
        if ((PROBE_DUP >> 11) & 1) { xcd_barrier(bar); { moe_gemm<2>(a, lds, 0); } }
        SEAM(11); }
    if (IN(12)) { row_phase<2>(a, lds, 0, NROW);
        if ((PROBE_DUP >> 12) & 1) { xcd_barrier(bar); { row_phase<2>(a, lds, 0, NROW); } }
        SEAM(12); }
    if (IN(13)) { pg8::DenseOrder S; S.init(NROW, 3072, 512, ws + WS_WQKV, G, c); S.fill_rowtab((LAS int*)(lds + pg8::STAGE_BYTES)); pg8::EpiBf16 E{(bf16_t*)(ws + WS_P), 3072}; pg8::gemm_phase<true, true, 127, 121>(lds, ws + WS_H, 512, S, E); __syncthreads();
        if ((PROBE_DUP >> 13) & 1) { xcd_barrier(bar); { pg8::DenseOrder S; S.init(NROW, 3072, 512, ws + WS_WQKV, G, c); S.fill_rowtab((LAS int*)(lds + pg8::STAGE_BYTES)); pg8::EpiBf16 E{(bf16_t*)(ws + WS_P), 3072}; pg8::gemm_phase<true, true, 127, 121>(lds, ws + WS_H, 512, S, E); __syncthreads(); } }
        SEAM(13); }
    if (IN(14)) { na_phase(a, lds);
        if ((PROBE_DUP >> 14) & 1) { xcd_barrier(bar); { na_phase(a, lds); } }
        SEAM(14); }
    if (IN(15)) { pg8::DenseOrder S; S.init(NLAT, 1024, 512, ws + WS_WO, G, c); S.fill_rowtab((LAS int*)(lds + pg8::STAGE_BYTES));
        pg8::EpiResid<true> E{nullptr, nullptr, (bf16_t*)(ws + WS_XS), (const float*)(ws + WS_MODF) + 3 * 6144 + 2 * 1024};
        pg8::gemm_phase<true, true, 124, 121>(lds, ws + WS_AR, 512, S, E); __syncthreads();
        if ((PROBE_DUP >> 15) & 1) { xcd_barrier(bar); { pg8::DenseOrder S; S.init(NLAT, 1024, 512, ws + WS_WO, G, c); S.fill_rowtab((LAS int*)(lds + pg8::STAGE_BYTES));
        pg8::EpiResid<true> E{nullptr, nullptr, (bf16_t*)(ws + WS_XS), (const float*)(ws + WS_MODF) + 3 * 6144 + 2 * 1024};
        pg8::gemm_phase<true, true, 124, 121>(lds, ws + WS_AR, 512, S, E); __syncthreads(); } }
        SEAM(15); }
    if (IN(16)) { router_phase(a, lds, 1, NLAT);
        if ((PROBE_DUP >> 16) & 1) { xcd_barrier(bar); { router_phase(a, lds, 1, NLAT); } }
        SEAM(16); }
    if (IN(17)) { slots_phase(a, lds, NLAT);
        if ((PROBE_DUP >> 17) & 1) { xcd_barrier(bar); { slots_phase(a, lds, NLAT); } }
        SEAM(17); }
    if (IN(18)) { moe_gemm<1>(a, lds, 1);
        if ((PROBE_DUP >> 18) & 1) { xcd_barrier(bar); { moe_gemm<1>(a, lds, 1); } }
        SEAM(18); }
    if (IN(19)) { moe_gemm<2>(a, lds, 1);
        if ((PROBE_DUP >> 19) & 1) { xcd_barrier(bar); { moe_gemm<2>(a, lds, 1); } }
        SEAM(19); }
    if (IN(20)) { row_phase<3>(a, lds, 1, NLAT);
        if ((PROBE_DUP >> 20) & 1) { xcd_barrier(bar); { row_phase<3>(a, lds, 1, NLAT); } }
        }
#undef IN
#undef SEAM
}

#ifndef MK_PER_PHASE
#define MK_PER_PHASE 0
#endif
extern "C" void kernel_launch(void* const* d_in, const int* in_sizes, int n_in, void* d_out, int out_size, void* d_ws, size_t ws_size, hipStream_t stream) {
    static int grid = 0;
    if (grid == 0) {
        if (n_in != N_IN || ws_size < WS_END) { fprintf(stderr, "kernel_launch: unexpected n_in %d or ws %zu < %zu\n", n_in, ws_size, (size_t)WS_END); grid = -1; return; }
        int dev = 0, cus = 0, per_cu = 0;
        if (hipGetDevice(&dev) != hipSuccess || hipDeviceGetAttribute(&cus, hipDeviceAttributeMultiprocessorCount, dev) != hipSuccess) { grid = -1; return; }
        if (hipFuncSetAttribute((const void*)mega, hipFuncAttributeMaxDynamicSharedMemorySize, LDS_BYTES) != hipSuccess) { fprintf(stderr, "kernel_launch: hipFuncSetAttribute failed\n"); grid = -1; return; }
        if (hipOccupancyMaxActiveBlocksPerMultiprocessor(&per_cu, (const void*)mega, NTHR, LDS_BYTES) != hipSuccess || per_cu < 1) fprintf(stderr, "kernel_launch: occupancy query says %d\n", per_cu);
        (void)hipGetLastError();
        grid = cus;
        if (grid != 256) { fprintf(stderr, "kernel_launch: expected 256 CUs, got %d\n", grid); grid = 256; }
    }
    if (grid < 0) return;
    (void)in_sizes; (void)out_size;
    (void)hipMemsetAsync((char*)d_ws + WS_CTL, 0, CTL_BYTES, stream);
    Args a{};
    for (int i = 0; i < N_IN; ++i) a.in[i] = (const float*)d_in[i];
    a.out = (float*)d_out; a.ws = (unsigned char*)d_ws;
#if MK_PER_PHASE
    for (int p = 0; p < NPH; ++p) { a.ph_lo = p; a.ph_hi = p + 1; hipLaunchKernelGGL(mega, dim3(grid), dim3(NTHR), LDS_BYTES, stream, a); }
#else
    a.ph_lo = 0; a.ph_hi = NPH; hipLaunchKernelGGL(mega, dim3(grid), dim3(NTHR), LDS_BYTES, stream, a);
#endif
}
```

```cpp
#include <hip/hip_runtime.h>
#include <cstdio>
#include <cstdint>

#define DI __device__ __forceinline__
#define LAS __attribute__((address_space(3)))
#define GAS __attribute__((address_space(1)))
typedef unsigned short bf16_t;
typedef short bf16x8 __attribute__((ext_vector_type(8)));
typedef short s16x4 __attribute__((ext_vector_type(4)));
typedef float f32x4 __attribute__((ext_vector_type(4)));
typedef float f32x2 __attribute__((ext_vector_type(2)));
typedef float f32x16 __attribute__((ext_vector_type(16)));
typedef unsigned u32x4 __attribute__((ext_vector_type(4)));
typedef unsigned u32x2 __attribute__((ext_vector_type(2)));

constexpr int DM = 1024, NLAT = 32768, NCTX = 512, NROW = NLAT + NCTX, SEQ = 16384, CTXL = 256;
constexpr int NTHR = 512, NWAVE = 8;
constexpr int LDS_BYTES = 156 * 1024;
constexpr int LDS_CTL_OFF = LDS_BYTES - 256;
constexpr int MAXSLOT = 4 * NROW + 32 * 256;
constexpr int MAXTILE = MAXSLOT / 256;

enum { I_X = 0, I_C, I_CTX, I_CCTX, I_ADAW, I_ADAB, I_NORMW, I_FNW, I_WIN, I_WOUT, I_LRE, I_LIM, I_LSTEP, I_BRE, I_BIM, I_CRE, I_CIM, I_S5D, I_WGLU,
       I_DECAY, I_WQKV, I_WO, I_RPB, I_WR, I_BR, I_W1, I_B1, I_W2, I_B2, N_IN };

constexpr size_t MiB = 1u << 20;
constexpr size_t al(size_t x) { return (x + 4095) & ~(size_t)4095; }
constexpr size_t WS_CTL = 0, CTL_BYTES = 1 * MiB;
constexpr size_t WS_MODP = WS_CTL + CTL_BYTES;
constexpr size_t WS_MODF = WS_MODP + al(8 * 2 * 3 * 6144 * 4);
constexpr size_t WS_ROPE = WS_MODF + al(2 * 3 * 6144 * 4);
constexpr size_t WS_S5A = WS_ROPE + al(256 * 32 * 8);
constexpr size_t WS_S5BF = WS_S5A + al(2 * 32 * 64 * 16);
constexpr size_t WS_S5CF = WS_S5BF + al(2 * 32 * 4 * 64 * 16);
constexpr size_t WS_S5E = WS_S5CF + al(2 * 32 * 4 * 64 * 16);
constexpr size_t WS_S5H = WS_S5E + al((size_t)2 * 2 * 32 * 130 * 64 * 8);
constexpr size_t WS_WRT = WS_S5H + al((size_t)2 * 2 * 32 * 130 * 64 * 8);
constexpr size_t WS_WIN = WS_WRT + al(2 * 32 * 1024 * 4);
constexpr size_t WS_WOUT = WS_WIN + al((size_t)2560 * 1024 * 2);
constexpr size_t WS_WGLU = WS_WOUT + al((size_t)1024 * 1024 * 2);
constexpr size_t WS_WQKV = WS_WGLU + al((size_t)512 * 512 * 2);
constexpr size_t WS_WO = WS_WQKV + al((size_t)3072 * 1024 * 2);
constexpr size_t WS_W1 = WS_WO + al((size_t)1024 * 1024 * 2);
constexpr size_t WS_W2 = WS_W1 + al((size_t)2 * 32 * 2048 * 1024 * 2);
constexpr size_t WS_XS = WS_W2 + al((size_t)2 * 32 * 1024 * 1024 * 2);
constexpr size_t WS_H = WS_XS + al((size_t)NROW * 1024 * 4);
constexpr size_t WS_P = WS_H + al((size_t)NROW * 1024 * 2);
constexpr size_t WS_AR = WS_P + al((size_t)NROW * 3072 * 2);
constexpr size_t WS_YG = WS_AR + al((size_t)NROW * 1024 * 2);
constexpr size_t WS_KVL = WS_YG + al((size_t)NROW * 512 * 2);
constexpr size_t WS_SIN = WS_KVL + al((size_t)2 * 4 * 2 * 130 * 16384 * 4);
constexpr size_t WS_ACT = WS_SIN + al((size_t)2 * 4 * 2 * 130 * 16384 * 2);
constexpr size_t WS_Y2 = WS_ACT + al((size_t)MAXSLOT * 1024 * 2);
constexpr size_t WS_SEL = WS_Y2 + al((size_t)MAXSLOT * 1024 * 2);
constexpr size_t WS_GATE = WS_SEL + al((size_t)NROW * 16);
constexpr size_t WS_RSLOT = WS_GATE + al((size_t)NROW * 16);
constexpr size_t WS_STOK = WS_RSLOT + al((size_t)NROW * 16);
constexpr size_t WS_CNT = WS_STOK + al((size_t)MAXSLOT * 4);
constexpr size_t WS_ETOT = WS_CNT + al(256 * 32 * 4);
constexpr size_t WS_END = WS_ETOT + 4096;

DI unsigned f2bf(float f) { unsigned u = __builtin_bit_cast(unsigned, f); return (u + 0x7fffu + ((u >> 16) & 1u)) >> 16; }
typedef __bf16 hbf16x2 __attribute__((ext_vector_type(2)));
DI unsigned pk2(float lo, float hi) { f32x2 v = {lo, hi}; hbf16x2 b = __builtin_convertvector(v, hbf16x2); return __builtin_bit_cast(unsigned, b); }
DI unsigned pk4_fp8(float a, float b, float c, float d) { int w = 0; w = __builtin_amdgcn_cvt_pk_fp8_f32(a, b, w, false); w = __builtin_amdgcn_cvt_pk_fp8_f32(c, d, w, true); return (unsigned)w; }
DI float bflo(unsigned w) { return __builtin_bit_cast(float, w << 16); }
DI float bfhi(unsigned w) { return __builtin_bit_cast(float, w & 0xffff0000u); }
DI float bf1(bf16_t b) { return __builtin_bit_cast(float, (unsigned)b << 16); }
DI void st_i(int* p, int v) { __hip_atomic_store(p, v, __ATOMIC_RELAXED, __HIP_MEMORY_SCOPE_AGENT); }
DI void st_f(float* p, float v) { __hip_atomic_store(p, v, __ATOMIC_RELAXED, __HIP_MEMORY_SCOPE_AGENT); }
DI int ld_i(const int* p) { return __hip_atomic_load(p, __ATOMIC_RELAXED, __HIP_MEMORY_SCOPE_AGENT); }
DI float ld_f(const float* p) { return __hip_atomic_load(p, __ATOMIC_RELAXED, __HIP_MEMORY_SCOPE_AGENT); }
DI int crow(int reg, int h) { return (reg & 3) + 8 * (reg >> 2) + 4 * h; }
DI float sigmoidf_(float x) { return __builtin_amdgcn_rcpf(1.0f + __expf(-x)); }
DI float ex2(float x) { return __builtin_amdgcn_exp2f(x); }
#define MFMA32(a, b, c) __builtin_amdgcn_mfma_f32_32x32x16_bf16((a), (b), (c), 0, 0, 0)
#define MFMA16(a, b, c) __builtin_amdgcn_mfma_f32_16x16x32_bf16((a), (b), (c), 0, 0, 0)
#define LDS_WAIT() asm volatile("s_waitcnt lgkmcnt(0)" ::: "memory")
#define VM_WAIT() asm volatile("s_waitcnt vmcnt(0)" ::: "memory")
DI bf16x8 tr_read2(unsigned a_lo, unsigned a_hi) {
    s16x4 lo, hi;
    asm volatile("ds_read_b64_tr_b16 %0, %2\n\tds_read_b64_tr_b16 %1, %3\n\ts_waitcnt lgkmcnt(0)" : "=&v"(lo), "=&v"(hi) : "v"(a_lo), "v"(a_hi) : "memory");
    return __builtin_shufflevector(lo, hi, 0, 1, 2, 3, 4, 5, 6, 7);
}
DI bf16x8 pack8(const f32x16& x, int s) {
    u32x4 p; p[0] = pk2(x[8 * s], x[8 * s + 1]); p[1] = pk2(x[8 * s + 2], x[8 * s + 3]); p[2] = pk2(x[8 * s + 4], x[8 * s + 5]); p[3] = pk2(x[8 * s + 6], x[8 * s + 7]);
    return __builtin_bit_cast(bf16x8, p);
}
DI f32x16 zero16() { f32x16 z; for (int i = 0; i < 16; ++i) z[i] = 0.f; return z; }

#define XB_TMO      128
#define XB_XCNT(j)  (256  + 64 * (j))
#define XB_FLX(x)   (4096 + 256 * (x))
#define XB_TOPF     16384
#define XB_SPIN_CAP (1u << 22)
DI unsigned xb_ld(unsigned* p)              { return __hip_atomic_load(p, __ATOMIC_RELAXED, __HIP_MEMORY_SCOPE_AGENT); }
DI void xb_st(unsigned* p, unsigned v)      { __hip_atomic_store(p, v, __ATOMIC_RELAXED, __HIP_MEMORY_SCOPE_AGENT); }
DI unsigned xb_add(unsigned* p, unsigned v) { return __hip_atomic_fetch_add(p, v, __ATOMIC_RELAXED, __HIP_MEMORY_SCOPE_AGENT); }
DI unsigned xb_xcc_id() { return (unsigned)__builtin_amdgcn_s_getreg((3 << 11) | 20) & 0xFu; }
struct XcdBarrier { unsigned* bar; unsigned x; volatile LAS unsigned* st; };
DI XcdBarrier xcd_barrier_post(unsigned* bar, volatile LAS unsigned* st) {
    XcdBarrier b; b.bar = bar; b.x = xb_xcc_id(); b.st = st;
    if (threadIdx.x == 0) st[3] = xb_add(&bar[XB_XCNT(b.x)], 1u);
    return b;
}
DI void xcd_barrier_complete(unsigned* bar, unsigned x, unsigned& nloc, unsigned& xmask) {
    const unsigned G = gridDim.x * gridDim.y * gridDim.z;
    unsigned sum, msk, mine, sp = 0u;
    for (;;) {
        sum = 0u; msk = 0u; mine = 0u;
#pragma unroll
        for (unsigned j = 0; j < 16; ++j) { const unsigned c = xb_ld(&bar[XB_XCNT(j)]); sum += c; msk |= (c > 0u) ? (1u << j) : 0u; mine = (j == x) ? c : mine; }
        if (sum == G) break;
        __builtin_amdgcn_s_sleep(1);
        if ((++sp & 255u) == 0u) { if (xb_ld(&bar[XB_TMO])) break; if (sp > XB_SPIN_CAP) { atomicAdd(&bar[XB_TMO], 1u); break; } }
    }
    nloc = mine > 0u ? mine : 1u; xmask = msk ? msk : 1u;
}
DI void xcd_barrier(const XcdBarrier& b) {
    asm volatile("s_waitcnt vmcnt(0)" ::: "memory");
    __syncthreads();
    if (threadIdx.x < 64) {
        const unsigned lane = threadIdx.x; unsigned* bar = b.bar;
        __builtin_amdgcn_s_waitcnt(0);
        unsigned nloc = b.st[0], xmask = b.st[1];
        const unsigned kk = b.st[2] + 1u, rank = b.st[3];
        if (nloc == 0u) { xcd_barrier_complete(bar, b.x, nloc, xmask); if (lane == 0u) { b.st[0] = nloc; b.st[1] = xmask; } }
        if (lane == 0u) xb_st(&bar[XB_FLX(b.x) + rank], kk);
        if (rank == 0u) {
            unsigned sp = 0u;
            for (;;) {
                bool ok = true;
                for (unsigned base = 0u; base < nloc; base += 64u) { const unsigned j = base + lane; const unsigned v = j < nloc ? xb_ld(&bar[XB_FLX(b.x) + j]) : kk; ok = ok && ((int)(v - kk) >= 0); }
                if (__all(ok)) break;
                __builtin_amdgcn_s_sleep(1);
                if ((++sp & 255u) == 0u) { if (xb_ld(&bar[XB_TMO])) break; if (sp > XB_SPIN_CAP) { if (lane == 0u) atomicAdd(&bar[XB_TMO], 1u); break; } }
            }
            if (lane == 0u) {
                __builtin_amdgcn_fence(__ATOMIC_RELEASE, "agent");
                asm volatile("s_waitcnt vmcnt(0)\n\tbuffer_inv sc1\n\ts_waitcnt vmcnt(0)" ::: "memory");
                xb_st(&bar[XB_TOPF + b.x], kk);
            }
        } else if (lane == 0u) {
            asm volatile("buffer_inv sc0" ::: "memory");
        }
        {
            unsigned sp = 0u;
            for (;;) {
                const unsigned v = (lane < 16u && ((xmask >> lane) & 1u)) ? xb_ld(&bar[XB_TOPF + lane]) : kk;
                if (__all((int)(v - kk) >= 0)) break;
                __builtin_amdgcn_s_sleep(1);
                if ((++sp & 255u) == 0u) { if (xb_ld(&bar[XB_TMO])) break; if (sp > XB_SPIN_CAP) { if (lane == 0u) atomicAdd(&bar[XB_TMO], 1u); break; } }
            }
        }
        asm volatile("s_waitcnt vmcnt(0)" ::: "memory");
        if (lane == 0u) b.st[2] = kk;
    }
    __syncthreads();
}

struct Args { const float* in[N_IN]; float* out; unsigned char* ws; int ph_lo, ph_hi; };

DI int chunk_row0(int b, int mc) { return mc < 128 ? b * SEQ + mc * 128 : NLAT + b * CTXL + (mc - 128) * 128; }
DI int row_s(int row) { return row < SEQ ? 0 : (row < NLAT ? 1 : 2); }

DI void transpose_item(const float* W, int K, int N, bf16_t* WT, int nout0, LAS float* scr, int k0, int n0, int lane) {
    float tmp[32];
    const float* wp = W + (size_t)(k0 + (lane >> 5)) * N + n0 + (lane & 31);
#pragma unroll
    for (int i = 0; i < 32; ++i) tmp[i] = wp[(size_t)(2 * i) * N];
#pragma unroll
    for (int i = 0; i < 32; ++i) { const int kk = 2 * i + (lane >> 5); scr[kk * 33 + (lane & 31)] = tmp[i]; }
    LDS_WAIT();
    const int c = lane & 7;
#pragma unroll
    for (int j = 0; j < 4; ++j) { const int n = (lane >> 3) + 8 * j; const LAS float* s = scr + (8 * c) * 33 + n;
        u32x4 o; o[0] = pk2(s[0 * 33], s[1 * 33]); o[1] = pk2(s[2 * 33], s[3 * 33]); o[2] = pk2(s[4 * 33], s[5 * 33]); o[3] = pk2(s[6 * 33], s[7 * 33]);
        *(u32x4*)(WT + (size_t)(nout0 + n) * K + k0 + 8 * c) = o; }
    LDS_WAIT();
}

DI void transpose_item_fp8(const float* W, int K, int N, unsigned char* WT, int nout0, LAS float* scr, int k0, int n0, int lane, float wscale) {
    float tmp[64];
    const float* wp = W + (size_t)(k0 + (lane >> 5)) * N + n0 + (lane & 31);
#pragma unroll
    for (int i = 0; i < 64; ++i) tmp[i] = wp[(size_t)(2 * i) * N];
#pragma unroll
    for (int i = 0; i < 64; ++i) { const int kk = 2 * i + (lane >> 5); scr[kk * 33 + (lane & 31)] = tmp[i] * wscale; }
    LDS_WAIT();
    const int c = lane & 15;
#pragma unroll
    for (int j = 0; j < 8; ++j) { const int n = (lane >> 4) + 4 * j; const LAS float* s = scr + (8 * c) * 33 + n;
        u32x2 o; o[0] = pk4_fp8(s[0 * 33], s[1 * 33], s[2 * 33], s[3 * 33]); o[1] = pk4_fp8(s[4 * 33], s[5 * 33], s[6 * 33], s[7 * 33]);
        *(u32x2*)(WT + (size_t)(nout0 + n) * K + k0 + 8 * c) = o; }
    LDS_WAIT();
}

DI void p0_prologue(const Args& a, LAS unsigned char* lds) {
    const int tid = threadIdx.x, lane = tid & 63, wave = tid >> 6;
    unsigned char* ws = a.ws;
    const int gw = blockIdx.x * NWAVE + wave, NGW = gridDim.x * NWAVE;
    const int gt = blockIdx.x * NTHR + tid, NGT = gridDim.x * NTHR;
    LAS float* scr = (LAS float*)(lds + wave * 17408);
    constexpr int T_IN = 8 * 80, T_OUT = 16 * 32, T_GLU = 8 * 16, T_QKV = 8 * 96, T_OO = 8 * 32, T_W1 = 64 * 8 * 64, T_W2 = 64 * 8 * 32;
    constexpr int NITEMS = T_IN + T_OUT + T_GLU + T_QKV + T_OO + T_W1 + T_W2;
    for (int it = gw; it < NITEMS; it += NGW) {
        int r = it;
        if (r < T_IN) { const int kb = r / 80, nb = r % 80; transpose_item_fp8(a.in[I_WIN], 1024, 2560, ws + WS_WIN, 32 * nb, scr, 128 * kb, 32 * nb, lane, 64.0f); continue; } r -= T_IN;
        if (r < T_OUT) { const int kb = r / 32, nb = r % 32; transpose_item(a.in[I_WOUT], 1024, 1024, (bf16_t*)(ws + WS_WOUT), 32 * nb, scr, 64 * kb, 32 * nb, lane); continue; } r -= T_OUT;
        if (r < T_GLU) { const int kb = r / 16, nb = r % 16; transpose_item(a.in[I_WGLU], 512, 512, (bf16_t*)(ws + WS_WGLU), 32 * nb, scr, 64 * kb, 32 * nb, lane); continue; } r -= T_GLU;
        if (r < T_QKV) { const int kb = r / 96, nb = r % 96; transpose_item_fp8(a.in[I_WQKV], 1024, 3072, ws + WS_WQKV, 32 * nb, scr, 128 * kb, 32 * nb, lane, 64.0f); continue; } r -= T_QKV;
        if (r < T_OO) { const int kb = r / 32, nb = r % 32; transpose_item_fp8(a.in[I_WO], 1024, 1024, ws + WS_WO, 32 * nb, scr, 128 * kb, 32 * nb, lane, 64.0f); continue; } r -= T_OO;
        if (r < T_W1) { const int m = r / 512, q = r % 512, kb = q / 64, nb = q % 64, n0 = 32 * nb;
            const int np = ((n0 & 1023) >> 7) * 256 + (n0 >> 10) * 128 + (n0 & 127);
            transpose_item_fp8(a.in[I_W1] + (size_t)m * 1024 * 2048, 1024, 2048, ws + WS_W1 + (size_t)m * 2048 * 1024, np, scr, 128 * kb, n0, lane, 64.0f); continue; } r -= T_W1;
        { const int m = r / 256, q = r % 256, kb = q / 32, nb = q % 32;
            transpose_item_fp8(a.in[I_W2] + (size_t)m * 1024 * 1024, 1024, 1024, ws + WS_W2 + (size_t)m * 1024 * 1024, 32 * nb, scr, 128 * kb, 32 * nb, lane, 64.0f); }
    }
    __syncthreads();
    {
        LAS float* cond = (LAS float*)lds;
        for (int i = tid; i < 3 * 1024; i += NTHR) { const int s = i >> 10, k = i & 1023; const float v = s < 2 ? a.in[I_C][s * 1024 + k] : a.in[I_CCTX][k]; cond[i] = v / (1.0f + __expf(-v)); }
        __syncthreads();
        float* modp = (float*)(ws + WS_MODP);
        for (int it = gw; it < 2 * 8 * 24; it += NGW) {
            const int l = it / 192, q = it % 192, ks = q / 24, nb = q % 24, n = nb * 256 + lane * 4;
            f32x4 acc0 = {0, 0, 0, 0}, acc1 = {0, 0, 0, 0}, acc2 = {0, 0, 0, 0};
            const float* wp = a.in[I_ADAW] + (size_t)l * 1024 * 6144 + (size_t)(ks * 128) * 6144 + n;
#pragma unroll 8
            for (int k = 0; k < 128; ++k) { const f32x4 w = *(const f32x4*)(wp + (size_t)k * 6144); const int kk = ks * 128 + k;
                acc0 += w * cond[kk]; acc1 += w * cond[1024 + kk]; acc2 += w * cond[2048 + kk]; }
            float* o = modp + ((size_t)(ks * 2 + l) * 3) * 6144 + n;
            *(f32x4*)(o) = acc0; *(f32x4*)(o + 6144) = acc1; *(f32x4*)(o + 2 * 6144) = acc2;
        }
    }
    for (int i = gt; i < 256 * 32; i += NGT) { const int pos = i >> 5, f = i & 31; const double fr = pow(10000.0, -(double)f / 32.0), ang = (double)pos * fr;
        ((f32x2*)(ws + WS_ROPE))[i] = (f32x2){(float)cos(ang), (float)sin(ang)}; }
    for (int i = gt; i < 2 * 32 * 1024; i += NGT) { const int l = i >> 15, e = (i >> 10) & 31, k = i & 1023; ((float*)(ws + WS_WRT))[i] = a.in[I_WR][(size_t)l * 32768 + k * 32 + e]; }
    for (int i = gt; i < 2 * 32 * 64; i += NGT) {
        const int dr = i >> 11, g = (i >> 6) & 31, ln = i & 63;
        const double st = exp((double)a.in[I_LSTEP][dr * 32 + g]);
        {
            const int p = ln; double lre = (double)a.in[I_LRE][(dr * 32 + g) * 64 + p]; if (lre > -1e-4) lre = -1e-4; const double lim = (double)a.in[I_LIM][(dr * 32 + g) * 64 + p];
            const double mag = exp(lre * st), ang = lim * st; double ar = mag * cos(ang), ai = mag * sin(ang);
            double pr = ar, pi = ai;
            for (int q = 0; q < 7; ++q) { const double nr = pr * pr - pi * pi, ni = 2.0 * pr * pi; pr = nr; pi = ni; }
            ((f32x4*)(ws + WS_S5A))[i] = (f32x4){(float)ar, (float)ai, (float)pr, (float)pi};
        }
        const int h = ln >> 5, cl = ln & 31;
#pragma unroll
        for (int m = 0; m < 4; ++m) {
            const int p = 32 * (m >> 1) + cl;
            double lre = (double)a.in[I_LRE][(dr * 32 + g) * 64 + p]; if (lre > -1e-4) lre = -1e-4; const double lim = (double)a.in[I_LIM][(dr * 32 + g) * 64 + p];
            const double mag = exp(lre * st), ang = lim * st, ar = mag * cos(ang), ai = mag * sin(ang);
            const double den = lre * lre + lim * lim, nre = ar - 1.0, nim = ai;
            const double cre = (nre * lre + nim * lim) / den, cim = (nim * lre - nre * lim) / den;
            float v[8];
#pragma unroll
            for (int jj = 0; jj < 8; ++jj) { const int ii = 8 * h + jj; const double br = (double)a.in[I_BRE][((size_t)(dr * 32 + g) * 64 + p) * 16 + ii], bi = (double)a.in[I_BIM][((size_t)(dr * 32 + g) * 64 + p) * 16 + ii];
                v[jj] = (m & 1) ? (float)(cre * bi + cim * br) : (float)(cre * br - cim * bi); }
            u32x4 o; o[0] = pk2(v[0], v[1]); o[1] = pk2(v[2], v[3]); o[2] = pk2(v[4], v[5]); o[3] = pk2(v[6], v[7]);
            ((u32x4*)(ws + WS_S5BF))[((dr * 32 + g) * 4 + m) * 64 + ln] = o;
        }
        const int ci = ln & 15, quad = ln >> 4;
#pragma unroll
        for (int ks = 0; ks < 4; ++ks) {
            float v[8];
#pragma unroll
            for (int jj = 0; jj < 8; ++jj) { const int kp = 32 * ks + 8 * quad + jj, p = kp >> 1;
                v[jj] = (kp & 1) ? -a.in[I_CIM][((size_t)(dr * 32 + g) * 16 + ci) * 64 + p] : a.in[I_CRE][((size_t)(dr * 32 + g) * 16 + ci) * 64 + p]; }
            u32x4 o; o[0] = pk2(v[0], v[1]); o[1] = pk2(v[2], v[3]); o[2] = pk2(v[4], v[5]); o[3] = pk2(v[6], v[7]);
            ((u32x4*)(ws + WS_S5CF))[((dr * 32 + g) * 4 + ks) * 64 + ln] = o;
        }
    }
}

DI float wave_sum(float v) {
#pragma unroll
    for (int o = 1; o < 64; o <<= 1) v += __shfl_xor(v, o);
    return v;
}
template <int MODE>
DI void row_phase(const Args& a, LAS unsigned char* lds, int layer, int nrows) {
    int tid = threadIdx.x; asm volatile("" : "+v"(tid));
    const int lane = tid & 63, wave = __builtin_amdgcn_readfirstlane(tid >> 6);
    unsigned char* ws = a.ws;
    LAS float* modl = (LAS float*)lds;
    LAS float* wrt = (LAS float*)(lds + 24576);
    LAS int* hist = (LAS int*)(lds + 24576 + 131072);
    const float* modp = (const float*)(ws + WS_MODP);
    float* modf = (float*)(ws + WS_MODF);
    const int nl = (MODE == 2) ? 1 : layer;
    const int csh = (MODE == 1) ? 3 : 0;
    const float* nwg = (MODE == 3) ? a.in[I_FNW] : a.in[I_NORMW] + (nl * 2 + (MODE == 1 ? 1 : 0)) * 1024;
    if (MODE == 0) {
        for (int i = tid; i < 3 * 2048; i += NTHR) { const int s = i / 2048, j = i % 2048, ch = j >> 10, jj = j & 1023;
            float v = a.in[I_ADAB][j];
            for (int ks = 0; ks < 8; ++ks) v += modp[((size_t)(ks * 2 + 0) * 3 + s) * 6144 + j];
            modl[(s * 2 + ch) * 1024 + jj] = ch ? nwg[jj] * (1.0f + v) : v; }
        for (int i = blockIdx.x * NTHR + tid; i < 2 * 3 * 6144; i += gridDim.x * NTHR) { const int l = i / 18432, q = i % 18432, s = q / 6144, j = q % 6144;
            float v = a.in[I_ADAB][l * 6144 + j];
            for (int ks = 0; ks < 8; ++ks) v += modp[((size_t)(ks * 2 + l) * 3 + s) * 6144 + j];
            modf[i] = v; }
    } else if (MODE != 3) {
        for (int i = tid; i < 3 * 2048; i += NTHR) { const int s = i / 2048, j = i % 2048, ch = j >> 10, jj = j & 1023;
            const float v = modf[((size_t)nl * 3 + s) * 6144 + csh * 1024 + j];
            modl[(s * 2 + ch) * 1024 + jj] = ch ? nwg[jj] * (1.0f + v) : v; }
    }
    if (MODE >= 2) for (int i = tid; i < 3 * 1024; i += NTHR) { const int s = i >> 10, j = i & 1023; modl[6144 + s * 1024 + j] = modf[((size_t)layer * 3 + s) * 6144 + 5 * 1024 + j]; }
    if (MODE == 3) for (int i = tid; i < 1024; i += NTHR) modl[9216 + i] = nwg[i];
    LAS int* slL = (LAS int*)(lds + 65536); LAS float* gkL = (LAS float*)(lds + 65536 + 4096);
    if (MODE >= 2) { const int rpb_ = nrows / gridDim.x, rb_ = blockIdx.x * rpb_;
        for (int i = tid; i < rpb_ * 4; i += NTHR) { slL[i] = ld_i((const int*)(ws + WS_RSLOT) + (size_t)rb_ * 4 + i); gkL[i] = ld_f((const float*)(ws + WS_GATE) + (size_t)rb_ * 4 + i); } }
    if (MODE == 1) {
        const float* wsrc = (const float*)(ws + WS_WRT) + (size_t)layer * 32768;
        for (int i = tid; i < 32768 / 4; i += NTHR) ((LAS f32x4*)wrt)[i] = ((const f32x4*)wsrc)[i];
        if (tid < 32) hist[tid] = 0;
    }
    __syncthreads();
    const int rpb = nrows / gridDim.x;
    const int rbase = blockIdx.x * rpb;
    bf16_t* xs = (bf16_t*)(ws + WS_XS);
    bf16_t* H = (bf16_t*)(ws + WS_H);
    if (MODE == 1) {
        LAS float* lg = (LAS float*)(lds + 24576 + 131072 + 128) + wave * 80;
        for (int rr = 2 * wave; rr < rpb; rr += 2 * NWAVE) {
            f32x4 hh[2][4]; float rstd2[2];
#pragma unroll
            for (int u = 0; u < 2; ++u) {
                const bf16_t* xrow = xs + (size_t)(rbase + rr + u) * 1024;
                float ss = 0.f;
#pragma unroll
                for (int j = 0; j < 4; ++j) { const u32x2 xw = ((const u32x2*)xrow)[64 * j + lane]; hh[u][j] = (f32x4){bflo(xw[0]), bfhi(xw[0]), bflo(xw[1]), bfhi(xw[1])}; ss += (hh[u][j][0] * hh[u][j][0] + hh[u][j][1] * hh[u][j][1]) + (hh[u][j][2] * hh[u][j][2] + hh[u][j][3] * hh[u][j][3]); }
                rstd2[u] = ss;
            }
#pragma unroll
            for (int o = 1; o < 64; o <<= 1) { rstd2[0] += __shfl_xor(rstd2[0], o); rstd2[1] += __shfl_xor(rstd2[1], o); }
#pragma unroll
            for (int u = 0; u < 2; ++u) {
                const int row = rbase + rr + u, s = row_s(row);
                const float rstd = 1.0f / sqrtf(rstd2[u] * (1.0f / 1024.0f) + 1e-6f);
#pragma unroll
                for (int j = 0; j < 4; ++j) { const f32x4 sh = *(const LAS f32x4*)(modl + (s * 2 + 0) * 1024 + 256 * j + 4 * lane), wsc = *(const LAS f32x4*)(modl + (s * 2 + 1) * 1024 + 256 * j + 4 * lane);
                    hh[u][j] = (hh[u][j] * rstd) * wsc + sh;
                    ((unsigned*)((unsigned char*)H + (size_t)row * 1024))[64 * j + lane] = pk4_fp8(hh[u][j][0], hh[u][j][1], hh[u][j][2], hh[u][j][3]); }
            }
            float acc[2][32];
#pragma unroll
            for (int e = 0; e < 32; ++e) { float s0 = 0.f, s1 = 0.f;
#pragma unroll
                for (int j = 0; j < 4; ++j) { const f32x4 w = *(const LAS f32x4*)(wrt + e * 1024 + 256 * j + 4 * lane);
                    s0 += (hh[0][j][0] * w[0] + hh[0][j][1] * w[1]) + (hh[0][j][2] * w[2] + hh[0][j][3] * w[3]);
                    s1 += (hh[1][j][0] * w[0] + hh[1][j][1] * w[1]) + (hh[1][j][2] * w[2] + hh[1][j][3] * w[3]); }
                acc[0][e] = s0; acc[1][e] = s1; }
            float r16[2][16], r8[2][8], r4[2][4], r2[2][2], r1[2];
#pragma unroll
            for (int u = 0; u < 2; ++u) {
                { const bool up = lane & 32;
#pragma unroll
                  for (int e = 0; e < 16; ++e) { const float keep = up ? acc[u][e + 16] : acc[u][e], send = up ? acc[u][e] : acc[u][e + 16]; r16[u][e] = keep + __shfl_xor(send, 32); } }
                { const bool up = lane & 16;
#pragma unroll
                  for (int e = 0; e < 8; ++e) { const float keep = up ? r16[u][e + 8] : r16[u][e], send = up ? r16[u][e] : r16[u][e + 8]; r8[u][e] = keep + __shfl_xor(send, 16); } }
                { const bool up = lane & 8;
#pragma unroll
                  for (int e = 0; e < 4; ++e) { const float keep = up ? r8[u][e + 4] : r8[u][e], send = up ? r8[u][e] : r8[u][e + 4]; r4[u][e] = keep + __shfl_xor(send, 8); } }
                { const bool up = lane & 4;
#pragma unroll
                  for (int e = 0; e < 2; ++e) { const float keep = up ? r4[u][e + 2] : r4[u][e], send = up ? r4[u][e] : r4[u][e + 2]; r2[u][e] = keep + __shfl_xor(send, 4); } }
                { const bool up = lane & 2; const float keep = up ? r2[u][1] : r2[u][0], send = up ? r2[u][0] : r2[u][1]; r1[u] = keep + __shfl_xor(send, 2); }
                r1[u] += __shfl_xor(r1[u], 1);
            }
            const int myexp = lane >> 1;
            const float bias = a.in[I_BR][layer * 32 + myexp];
            const float val0 = r1[0] + bias, val1 = r1[1] + bias;
            if (!(lane & 1)) { lg[myexp] = val0; lg[32 + myexp] = val1; }
            LDS_WAIT();
            int rank0 = 0, rank1 = 0;
#pragma unroll
            for (int q = 0; q < 8; ++q) { const f32x4 v0 = *(const LAS f32x4*)(lg + 4 * q), v1 = *(const LAS f32x4*)(lg + 32 + 4 * q);
#pragma unroll
                for (int t = 0; t < 4; ++t) { const int e2 = 4 * q + t;
                    rank0 += (v0[t] > val0 || (v0[t] == val0 && e2 < myexp)) ? 1 : 0;
                    rank1 += (v1[t] > val1 || (v1[t] == val1 && e2 < myexp)) ? 1 : 0; } }
            LAS f32x2* slot = (LAS f32x2*)(lg + 64);
            if (!(lane & 1)) { if (rank0 < 4) slot[rank0] = (f32x2){val0, __int_as_float(myexp)}; if (rank1 < 4) slot[4 + rank1] = (f32x2){val1, __int_as_float(myexp)}; }
            LDS_WAIT();
            if (lane < 2) {
                const int u = lane, row = rbase + rr + u;
                const f32x2 t0 = slot[4 * u], t1 = slot[4 * u + 1], t2 = slot[4 * u + 2], t3 = slot[4 * u + 3];
                const float e1 = __expf(t1[0] - t0[0]), e2 = __expf(t2[0] - t0[0]), e3 = __expf(t3[0] - t0[0]); const float inv = 1.0f / (1.0f + e1 + e2 + e3);
                const int x0 = __float_as_int(t0[1]), x1 = __float_as_int(t1[1]), x2 = __float_as_int(t2[1]), x3 = __float_as_int(t3[1]);
                int* sel = (int*)(ws + WS_SEL) + (size_t)row * 4; float* gt = (float*)(ws + WS_GATE) + (size_t)row * 4;
                st_i(sel, x0); st_i(sel + 1, x1); st_i(sel + 2, x2); st_i(sel + 3, x3);
                st_f(gt, inv); st_f(gt + 1, e1 * inv); st_f(gt + 2, e2 * inv); st_f(gt + 3, e3 * inv);
                atomicAdd((int*)&hist[x0], 1); atomicAdd((int*)&hist[x1], 1); atomicAdd((int*)&hist[x2], 1); atomicAdd((int*)&hist[x3], 1);
            }
            LDS_WAIT();
        }
    } else {
        const bf16_t* Y2 = (const bf16_t*)(ws + WS_Y2);
        for (int rr = 2 * wave; rr < rpb; rr += 2 * NWAVE) {
            f32x4 v[2][4]; int sl[2][4]; float gk[2][4];
#pragma unroll
            for (int u = 0; u < 2; ++u) {
                const int row = rbase + rr + u;
                if (MODE == 0) { const float* xrow = (row < NLAT ? a.in[I_X] + (size_t)row * 1024 : a.in[I_CTX] + (size_t)(row - NLAT) * 1024);
#pragma unroll
                    for (int j = 0; j < 4; ++j) v[u][j] = ((const f32x4*)xrow)[64 * j + lane]; }
                else { const bf16_t* xrow = xs + (size_t)row * 1024;
#pragma unroll
                    for (int j = 0; j < 4; ++j) { const u32x2 xw = ((const u32x2*)xrow)[64 * j + lane]; v[u][j] = (f32x4){bflo(xw[0]), bfhi(xw[0]), bflo(xw[1]), bfhi(xw[1])}; } }
                if (MODE >= 2) {
#pragma unroll
                    for (int k = 0; k < 4; ++k) { sl[u][k] = __builtin_amdgcn_readfirstlane(slL[(rr + u) * 4 + k]); gk[u][k] = __int_as_float(__builtin_amdgcn_readfirstlane(__float_as_int(gkL[(rr + u) * 4 + k]))); }
                }
            }
            if (MODE >= 2) {
                unsigned yw[2][4][4];
#pragma unroll
                for (int u = 0; u < 2; ++u)
#pragma unroll
                    for (int k = 0; k < 4; ++k) { const unsigned* yr = (const unsigned*)((const unsigned char*)Y2 + (size_t)sl[u][k] * 1024);
#pragma unroll
                        for (int j = 0; j < 4; ++j) yw[u][k][j] = yr[64 * j + lane]; }
#pragma unroll
                for (int u = 0; u < 2; ++u) {
                    const int row = rbase + rr + u, s = row_s(row);
#pragma unroll
                    for (int j = 0; j < 4; ++j) { f32x4 y = {0.f, 0.f, 0.f, 0.f};
#pragma unroll
                        for (int k = 0; k < 4; ++k) { const unsigned w = yw[u][k][j]; const float g = gk[u][k] * 0.0625f; const f32x2 lo = __builtin_amdgcn_cvt_pk_f32_fp8(w, false), hi = __builtin_amdgcn_cvt_pk_f32_fp8(w, true); y[0] += g * lo[0]; y[1] += g * lo[1]; y[2] += g * hi[0]; y[3] += g * hi[1]; }
                        const f32x4 g2 = *(const LAS f32x4*)(modl + 6144 + s * 1024 + 256 * j + 4 * lane); v[u][j] += g2 * y;
                        if (MODE == 2) { u32x2 o; o[0] = pk2(v[u][j][0], v[u][j][1]); o[1] = pk2(v[u][j][2], v[u][j][3]); ((u32x2*)(xs + (size_t)row * 1024))[64 * j + lane] = o; } }
                }
            }
            float ss2[2];
#pragma unroll
            for (int u = 0; u < 2; ++u) { float ss = 0.f;
#pragma unroll
                for (int j = 0; j < 4; ++j) ss += (v[u][j][0] * v[u][j][0] + v[u][j][1] * v[u][j][1]) + (v[u][j][2] * v[u][j][2] + v[u][j][3] * v[u][j][3]);
                ss2[u] = ss; }
#pragma unroll
            for (int o = 1; o < 64; o <<= 1) { ss2[0] += __shfl_xor(ss2[0], o); ss2[1] += __shfl_xor(ss2[1], o); }
#pragma unroll
            for (int u = 0; u < 2; ++u) {
                const int row = rbase + rr + u, s = row_s(row);
                const float rstd = __builtin_amdgcn_rsqf(ss2[u] * (1.0f / 1024.0f) + 1e-6f);
#pragma unroll
                for (int j = 0; j < 4; ++j) {
                    if (MODE == 3) { const f32x4 w = *(const LAS f32x4*)(modl + 9216 + 256 * j + 4 * lane); __builtin_nontemporal_store(v[u][j] * rstd * w, (f32x4*)(a.out + (size_t)row * 1024) + 64 * j + lane); }
                    else { const f32x4 sh = *(const LAS f32x4*)(modl + (s * 2 + 0) * 1024 + 256 * j + 4 * lane), wsc = *(const LAS f32x4*)(modl + (s * 2 + 1) * 1024 + 256 * j + 4 * lane);
                        const f32x4 hv = (v[u][j] * rstd) * wsc + sh;
                        if (true) { ((unsigned*)((unsigned char*)H + (size_t)row * 1024))[64 * j + lane] = pk4_fp8(hv[0], hv[1], hv[2], hv[3]); }
                        else { u32x2 o; o[0] = pk2(hv[0], hv[1]); o[1] = pk2(hv[2], hv[3]); ((u32x2*)(H + (size_t)row * 1024))[64 * j + lane] = o; } }
                }
            }
        }
    }
    if (MODE == 1) { __syncthreads(); if (tid < 32) st_i((int*)(ws + WS_CNT) + blockIdx.x * 32 + tid, hist[tid]); }
    __syncthreads();
}

DI void router_phase(const Args& a, LAS unsigned char* lds, int layer, int nrows) {
    int tid = threadIdx.x; asm volatile("" : "+v"(tid));
    const int lane = tid & 63, wave = __builtin_amdgcn_readfirstlane(tid >> 6);
    unsigned char* ws = a.ws;
    constexpr int RS = 2064;
    LAS float* modl = (LAS float*)lds;
    LAS unsigned char* hiP = lds + 24576;
    LAS unsigned char* loP = hiP + 32 * RS;
    LAS float* part = (LAS float*)hiP;
    LAS float* lg = part + 8192 + wave * 160;
    LAS int* hist = (LAS int*)(loP + 32 * RS);
    const float* modf = (const float*)(ws + WS_MODF);
    const float* nwg = a.in[I_NORMW] + (layer * 2 + 1) * 1024;
    for (int i = tid; i < 3 * 2048; i += NTHR) { const int s = i / 2048, j = i % 2048, ch = j >> 10, jj = j & 1023;
        const float v = modf[((size_t)layer * 3 + s) * 6144 + 3 * 1024 + j];
        modl[(s * 2 + ch) * 1024 + jj] = ch ? nwg[jj] * (1.0f + v) : v; }
    if (tid < 32) hist[tid] = 0;
    bf16x8 whi[8], wlo[8];
    { const float* wsrc = (const float*)(ws + WS_WRT) + (size_t)layer * 32768 + (lane & 31) * 1024 + 128 * wave + 8 * (lane >> 5);
#pragma unroll
      for (int t = 0; t < 8; ++t) { const f32x4 w0 = *(const f32x4*)(wsrc + 16 * t), w1 = *(const f32x4*)(wsrc + 16 * t + 4);
          u32x4 h, l;
          h[0] = pk2(w0[0], w0[1]); h[1] = pk2(w0[2], w0[3]); h[2] = pk2(w1[0], w1[1]); h[3] = pk2(w1[2], w1[3]);
          l[0] = pk2(w0[0] - bflo(h[0]), w0[1] - bfhi(h[0])); l[1] = pk2(w0[2] - bflo(h[1]), w0[3] - bfhi(h[1]));
          l[2] = pk2(w1[0] - bflo(h[2]), w1[1] - bfhi(h[2])); l[3] = pk2(w1[2] - bflo(h[3]), w1[3] - bfhi(h[3]));
          whi[t] = __builtin_bit_cast(bf16x8, h); wlo[t] = __builtin_bit_cast(bf16x8, l); } }
    const int rpb = nrows / gridDim.x, rbase = blockIdx.x * rpb, ntile = (rpb + 31) >> 5;
    const bf16_t* xs = (const bf16_t*)(ws + WS_XS);
    unsigned char* H = ws + WS_H;
    const int e2 = lane & 15, tk = lane >> 4;
    const float bias0 = a.in[I_BR][layer * 32 + e2], bias1 = a.in[I_BR][layer * 32 + 16 + e2];
    __syncthreads();
#pragma unroll 1
    for (int tile = 0; tile < ntile; ++tile) {
        u32x2 xw[4][4];
#pragma unroll
        for (int u = 0; u < 4; ++u) { const int rl = 32 * tile + 4 * wave + u; const bool ok = rl < rpb;
#pragma unroll
            for (int j = 0; j < 4; ++j) xw[u][j] = ok ? ((const u32x2*)(xs + (size_t)(rbase + rl) * 1024))[64 * j + lane] : (u32x2){0u, 0u}; }
        float ss[4];
#pragma unroll
        for (int u = 0; u < 4; ++u) { float t = 0.f;
#pragma unroll
            for (int j = 0; j < 4; ++j) { const float x0 = bflo(xw[u][j][0]), x1 = bfhi(xw[u][j][0]), x2 = bflo(xw[u][j][1]), x3 = bfhi(xw[u][j][1]); t += (x0 * x0 + x1 * x1) + (x2 * x2 + x3 * x3); }
            ss[u] = t; }
#pragma unroll
        for (int o = 1; o < 64; o <<= 1) {
#pragma unroll
            for (int u = 0; u < 4; ++u) ss[u] += __shfl_xor(ss[u], o); }
#pragma unroll
        for (int u = 0; u < 4; ++u) {
            const int rl = 32 * tile + 4 * wave + u, row = rbase + rl, s = row_s(row); const bool ok = rl < rpb;
            const float rstd = 1.0f / sqrtf(ss[u] * (1.0f / 1024.0f) + 1e-6f);
#pragma unroll
            for (int j = 0; j < 4; ++j) { const f32x4 sh = *(const LAS f32x4*)(modl + (s * 2 + 0) * 1024 + 256 * j + 4 * lane), wsc = *(const LAS f32x4*)(modl + (s * 2 + 1) * 1024 + 256 * j + 4 * lane);
                const f32x4 xv = {bflo(xw[u][j][0]), bfhi(xw[u][j][0]), bflo(xw[u][j][1]), bfhi(xw[u][j][1])};
                const f32x4 hv = (xv * rstd) * wsc + sh;
                u32x2 ph, pl; ph[0] = pk2(hv[0], hv[1]); ph[1] = pk2(hv[2], hv[3]);
                pl[0] = pk2(hv[0] - bflo(ph[0]), hv[1] - bfhi(ph[0])); pl[1] = pk2(hv[2] - bflo(ph[1]), hv[3] - bfhi(ph[1]));
                *(LAS u32x2*)(hiP + (4 * wave + u) * RS + (256 * j + 4 * lane) * 2) = ph;
                *(LAS u32x2*)(loP + (4 * wave + u) * RS + (256 * j + 4 * lane) * 2) = pl;
                if (ok) ((unsigned*)(H + (size_t)row * 1024))[64 * j + lane] = pk4_fp8(hv[0], hv[1], hv[2], hv[3]); }
        }
        __syncthreads();
        f32x16 acc0 = zero16(), acc1 = zero16();
        { const int aoff = (lane & 31) * RS + (128 * wave + 8 * (lane >> 5)) * 2;
#pragma unroll
          for (int hf = 0; hf < 2; ++hf) { bf16x8 ah[4], al[4];
#pragma unroll
              for (int t = 0; t < 4; ++t) { ah[t] = *(const LAS bf16x8*)(hiP + aoff + (4 * hf + t) * 32); al[t] = *(const LAS bf16x8*)(loP + aoff + (4 * hf + t) * 32); }
#pragma unroll
              for (int t = 0; t < 4; ++t) { acc0 = MFMA32(ah[t], whi[4 * hf + t], acc0); acc1 = MFMA32(ah[t], wlo[4 * hf + t], acc1); acc0 = MFMA32(al[t], whi[4 * hf + t], acc0); } } }
        __syncthreads();
#pragma unroll
        for (int r = 0; r < 16; ++r) { const int tok = (r & 3) + 8 * (r >> 2) + 4 * (lane >> 5); part[(wave * 32 + tok) * 32 + (lane & 31)] = acc0[r] + acc1[r]; }
        __syncthreads();
        { const int tokl = 4 * wave + tk;
          float v0 = bias0, v1 = bias1;
#pragma unroll
          for (int w = 0; w < 8; ++w) { v0 += part[(w * 32 + tokl) * 32 + e2]; v1 += part[(w * 32 + tokl) * 32 + 16 + e2]; }
          lg[tk * 32 + e2] = v0; lg[tk * 32 + 16 + e2] = v1;
          LDS_WAIT();
          int rank0 = 0, rank1 = 0;
#pragma unroll
          for (int q = 0; q < 8; ++q) { const f32x4 vv = *(const LAS f32x4*)(lg + tk * 32 + 4 * q);
#pragma unroll
              for (int t = 0; t < 4; ++t) { const int ex = 4 * q + t;
                  rank0 += (vv[t] > v0 || (vv[t] == v0 && ex < e2)) ? 1 : 0;
                  rank1 += (vv[t] > v1 || (vv[t] == v1 && ex < e2 + 16)) ? 1 : 0; } }
          LAS f32x2* slot = (LAS f32x2*)(lg + 128) + tk * 4;
          if (rank0 < 4) slot[rank0] = (f32x2){v0, __int_as_float(e2)};
          if (rank1 < 4) slot[rank1] = (f32x2){v1, __int_as_float(e2 + 16)};
          LDS_WAIT();
          const int rl = 32 * tile + tokl;
          if (e2 == 0 && rl < rpb) {
              const int row = rbase + rl;
              const f32x2 t0 = slot[0], t1 = slot[1], t2 = slot[2], t3 = slot[3];
              const float e1 = __expf(t1[0] - t0[0]), e2v = __expf(t2[0] - t0[0]), e3 = __expf(t3[0] - t0[0]); const float inv = 1.0f / (1.0f + e1 + e2v + e3);
              const int x0 = __float_as_int(t0[1]), x1 = __float_as_int(t1[1]), x2 = __float_as_int(t2[1]), x3 = __float_as_int(t3[1]);
              int* sel = (int*)(ws + WS_SEL) + (size_t)row * 4; float* gt = (float*)(ws + WS_GATE) + (size_t)row * 4;
              st_i(sel, x0); st_i(sel + 1, x1); st_i(sel + 2, x2); st_i(sel + 3, x3);
              st_f(gt, inv); st_f(gt + 1, e1 * inv); st_f(gt + 2, e2v * inv); st_f(gt + 3, e3 * inv);
              atomicAdd((int*)&hist[x0], 1); atomicAdd((int*)&hist[x1], 1); atomicAdd((int*)&hist[x2], 1); atomicAdd((int*)&hist[x3], 1);
          } }
        __syncthreads();
    }
    if (tid < 32) st_i((int*)(ws + WS_CNT) + blockIdx.x * 32 + tid, hist[tid]);
    __syncthreads();
}

typedef int i32x4_t __attribute__((ext_vector_type(4)));
DI void slots_phase(const Args& a, LAS unsigned char* lds, int nrows) {
    const int tid = threadIdx.x; unsigned char* ws = a.ws;
    LAS int* tot = (LAS int*)lds; LAS int* bef = tot + 32; LAS int* pst = tot + 64; LAS int* sell = tot + 128;
    const int* cnt = (const int*)(ws + WS_CNT);
    const int rpb = nrows / gridDim.x, rbase = blockIdx.x * rpb;
    {
        LAS int* ptot = sell + 1024; LAS int* pbef = ptot + 512;
        const int e = tid & 31, part = tid >> 5;
        int cv[16];
#pragma unroll
        for (int k = 0; k < 16; ++k) cv[k] = ld_i(cnt + (part * 16 + k) * 32 + e);
        int t = 0, bsum = 0;
#pragma unroll
        for (int k = 0; k < 16; ++k) { t += cv[k]; if (part * 16 + k < (int)blockIdx.x) bsum += cv[k]; }
        ptot[part * 32 + e] = t; pbef[part * 32 + e] = bsum;
        for (int i = tid; i < rpb * 4; i += NTHR) sell[i] = ld_i((const int*)(ws + WS_SEL) + (size_t)rbase * 4 + i);
        __syncthreads();
        if (tid < 32) { int tt = 0, bb2 = 0; for (int p = 0; p < 16; ++p) { tt += ptot[p * 32 + tid]; bb2 += pbef[p * 32 + tid]; } tot[tid] = tt; bef[tid] = bb2; }
    }
    __syncthreads();
    if (tid < 32) { int p = 0;
#pragma unroll
        for (int e = 0; e < 31; ++e) p += (e < tid) ? ((tot[e] + 255) & ~255) : 0;
        pst[tid] = p; }
    __syncthreads();
    int* stok = (int*)(ws + WS_STOK); int* rsl = (int*)(ws + WS_RSLOT);
    for (int i = tid; i < rpb * 4; i += NTHR) {
        const int e = sell[i]; int rank = 0;
        for (int r = 0; r < (i >> 2); ++r) { const i32x4_t v = ((const LAS i32x4_t*)sell)[r]; rank += (v[0] == e ? 1 : 0) + (v[1] == e ? 1 : 0) + (v[2] == e ? 1 : 0) + (v[3] == e ? 1 : 0); }
        const int pos = pst[e] + bef[e] + rank;
        st_i(stok + pos, rbase + (i >> 2)); st_i(rsl + (size_t)rbase * 4 + i, pos); }
    if (blockIdx.x < 32) { const int e = blockIdx.x; const int lo = pst[e] + tot[e], hi = pst[e] + ((tot[e] + 255) & ~255); for (int i = lo + tid; i < hi; i += NTHR) st_i(stok + i, 0); }
    if (blockIdx.x == 32 && tid < 32) st_i((int*)(ws + WS_ETOT) + tid, tot[tid]);
    __syncthreads();
}

namespace pg8 {
constexpr int BM = 256, BK = 64, HALF = 128, HTB = HALF * BK * 2, STAGE_BYTES = 8 * HTB, NXCD = 8, WGM = 8;
__host__ __device__ __forceinline__ int lds_byte(int r, int c) { const int st = (r >> 4) * 2 + (c >> 5), rr = r & 15, cc = c & 31, ob = rr * 64 + cc * 2; return st * 1024 + (ob ^ (((ob >> 9) & 1) << 5)); }
__host__ __device__ __forceinline__ void stage_rc(int b, int& R, int& C) { const int st = b / 1024, sb = b % 1024, swz = sb ^ (((sb >> 9) & 1) << 5); R = (st >> 1) * 16 + swz / 64; C = (st & 1) * 32 + (swz % 64) / 2; }
__host__ __device__ __forceinline__ int perm32(int rho) { const int n = rho >> 4, i = rho & 15; return 8 * (i >> 2) + 4 * n + (i & 3); }

struct Unit { unsigned boff; int arow0; int orow0; int pn; int e; };

struct DenseOrder {
    int nM, nN, nwg, G, c; const void* Bt; unsigned btile; const LAS int* rowtab;
    DI void init(int M, int N, int K, const void* Bt_, int G_, int c_) { nM = M / BM; nN = N / BM; nwg = nM * nN; G = G_; c = c_; Bt = Bt_; btile = (unsigned)(BM * K * 2); rowtab = nullptr; }
    DI void fill_rowtab(LAS int* rt) { Unit u; for (int i = 0; next(i, u); ++i) if (threadIdx.x < 256) rt[i * 256 + threadIdx.x] = u.arow0 + (int)threadIdx.x; rowtab = rt; __syncthreads(); }
    DI const void* wbase() const { return Bt; }
    DI bool next(int i, Unit& u) const {
        const long L = (long)i * G + c; if (L >= nwg) return false;
        int wgid = (int)L; { const int q = nwg / NXCD, r = nwg % NXCD, xcd = wgid % NXCD, off = wgid / NXCD; wgid = (xcd < r ? xcd * (q + 1) : r * (q + 1) + (xcd - r) * q) + off; }
        const int nig = WGM * nN, gid = wgid / nig, fm = gid * WGM, gsz = (nM - fm) < WGM ? (nM - fm) : WGM;
        const int pm = fm + ((wgid % nig) % gsz), pn = (wgid % nig) / gsz;
        u.boff = (unsigned)pn * btile; u.arow0 = pm * BM; u.orow0 = pm * BM; u.pn = pn; u.e = 0; return true;
    }
    DI int arow(int i, int r) const { return rowtab[i * 256 + r]; }
};
struct MoeOrder {
    int ntile, NPN, G, c; const void* W; unsigned wexp, btile; const LAS int* tile_e; const LAS int* tile_s0; const LAS int* rowtab;
    DI const void* wbase() const { return W; }
    DI int tile_of(int i, int& pn) const { const int x = c & 7, j = c >> 3, TX = (ntile + 7) >> 3, u = i * (G >> 3) + j, tl = u / NPN; pn = u % NPN; const int t = x * TX + tl; return (tl < TX && t < ntile) ? t : -1; }
    DI bool next(int i, Unit& u) const {
        int pn; const int t = tile_of(i, pn); if (t < 0) return false;
        const int e = __builtin_amdgcn_readfirstlane(tile_e[t]), s0 = __builtin_amdgcn_readfirstlane(tile_s0[t]);
        u.boff = (unsigned)e * wexp + (unsigned)pn * btile; u.arow0 = s0; u.orow0 = s0; u.pn = pn; u.e = e; return true;
    }
    DI int arow(int i, int r) const { return rowtab[i * 256 + r]; }
};

typedef int i32x8 __attribute__((ext_vector_type(8)));
typedef int i32x4 __attribute__((ext_vector_type(4)));
template <bool GATHER, bool FP8, int SA, int SB, int PROBEK = 0, class Epi, class Sched>
DI void gemm_phase(LAS unsigned char* lds, const void* Amat, int K, const Sched& S, const Epi& E) {
    const int tid = threadIdx.x, wid = __builtin_amdgcn_readfirstlane(tid >> 6), lane = tid & 63, wr = wid >> 2, wc = wid & 3, fr = lane & 15, fq = lane >> 4;
    const int nt = K / BK;
    unsigned rcpack = 0u; unsigned voffB[2], voffA[2];
#pragma unroll
    for (int i = 0; i < 2; ++i) { int R, C; stage_rc(tid * 16 + i * 8192, R, C); rcpack |= ((unsigned)R | ((unsigned)C << 8)) << (16 * i); const int Rb = Epi::PERM ? ((R & ~31) + perm32(R & 31)) : R; voffB[i] = (unsigned)(Rb * K + C) * 2u; voffA[i] = (unsigned)(R * K + C) * 2u; }
    const unsigned kstep = (unsigned)(BK * 2);
    const unsigned hstep = (unsigned)(HALF * K * 2);
    const unsigned ldsw = (unsigned)wid * 1024u;
    const int aoff = lds_byte(wr * 64 + fr, fq * 8), boff = lds_byte(wc * 32 + fr, fq * 8);
    const __amdgpu_buffer_rsrc_t rsA = __builtin_amdgcn_make_buffer_rsrc((void*)Amat, (short)0, PROBEK == 1 ? 0 : 0x7fffffff, 0x00020000);
    const __amdgpu_buffer_rsrc_t rsB = __builtin_amdgcn_make_buffer_rsrc((void*)S.wbase(), (short)0, PROBEK == 1 ? 0 : 0x7fffffff, 0x00020000);
#define PG8_SA(b, h) (((b) * 2 + (h)) * HTB)
#define PG8_SB(b, h) ((4 + (b) * 2 + (h)) * HTB)
#define PG8_STAGEB(bufoff, soff) do { const int _so = __builtin_amdgcn_readfirstlane((int)(soff)); _Pragma("unroll") for (int _i = 0; _i < 2; ++_i) \
        __builtin_amdgcn_raw_ptr_buffer_load_lds(rsB, (LAS void*)(lds + (bufoff) + ldsw + _i * 8192), 16, (int)voffB[_i], _so, 0, 0); } while (0)
#define PG8_STAGEA(bufoff, soff, v0, v1) do { const int _so = __builtin_amdgcn_readfirstlane((int)(soff)); \
        __builtin_amdgcn_raw_ptr_buffer_load_lds(rsA, (LAS void*)(lds + (bufoff) + ldsw), 16, (int)(v0), _so, 0, 0); \
        __builtin_amdgcn_raw_ptr_buffer_load_lds(rsA, (LAS void*)(lds + (bufoff) + ldsw + 8192), 16, (int)(v1), _so, 0, 0); } while (0)
#define PG8_LDA(dst, b, h) do { _Pragma("unroll") for (int m = 0; m < 4; ++m) { const i32x4 _lo = *(const LAS i32x4*)(lds + PG8_SA(b, h) + aoff + m * 2048), _hi = *(const LAS i32x4*)(lds + PG8_SA(b, h) + aoff + m * 2048 + 1024); dst[m] = __builtin_shufflevector(_lo, _hi, 0, 1, 2, 3, 4, 5, 6, 7); } } while (0)
#define PG8_LDB(dst, b, h) do { _Pragma("unroll") for (int n = 0; n < 2; ++n) { const i32x4 _lo = *(const LAS i32x4*)(lds + PG8_SB(b, h) + boff + n * 2048), _hi = *(const LAS i32x4*)(lds + PG8_SB(b, h) + boff + n * 2048 + 1024); dst[n] = __builtin_shufflevector(_lo, _hi, 0, 1, 2, 3, 4, 5, 6, 7); } } while (0)
#define PG8_LOH(x) __builtin_bit_cast(bf16x8, __builtin_shufflevector((x), (x), 0, 1, 2, 3))
#define PG8_HIH(x) __builtin_bit_cast(bf16x8, __builtin_shufflevector((x), (x), 4, 5, 6, 7))
#define PG8_MMA(ai, bj, At, Bt) do { if constexpr (PROBEK == 2) { _Pragma("unroll") for (int m = 0; m < 4; ++m) asm volatile("" :: "v"(At[m])); _Pragma("unroll") for (int n = 0; n < 2; ++n) asm volatile("" :: "v"(Bt[n])); } else { __builtin_amdgcn_s_setprio(1); _Pragma("unroll") for (int m = 0; m < 4; ++m) _Pragma("unroll") for (int n = 0; n < 2; ++n) { \
        if constexpr (FP8) acc[ai][bj][m][n] = __builtin_amdgcn_mfma_scale_f32_16x16x128_f8f6f4(Bt[n], At[m], acc[ai][bj][m][n], 0, 0, 0, SB * 0x01010101, 0, SA * 0x01010101); \
        else { acc[ai][bj][m][n] = __builtin_amdgcn_mfma_f32_16x16x32_bf16(PG8_LOH(Bt[n]), PG8_LOH(At[m]), acc[ai][bj][m][n], 0, 0, 0); \
               acc[ai][bj][m][n] = __builtin_amdgcn_mfma_f32_16x16x32_bf16(PG8_HIH(Bt[n]), PG8_HIH(At[m]), acc[ai][bj][m][n], 0, 0, 0); } } __builtin_amdgcn_s_setprio(0); } } while (0)
#define PG8_LSTAGEA(...) PG8_STAGEA(__VA_ARGS__)
#define PG8_LSTAGEB(...) PG8_STAGEB(__VA_ARGS__)
#define PG8_WAIT_V(n) asm volatile("s_waitcnt vmcnt(" #n ")" ::: "memory")
#define PG8_WAIT_L(n) asm volatile("s_waitcnt lgkmcnt(" #n ")" ::: "memory")
#define PG8_BAR __builtin_amdgcn_s_barrier()
#define PG8_SCHED __builtin_amdgcn_sched_barrier(0)
    Unit cur, nxt; int ui = 0;
    if (!S.next(0, cur)) return;
    unsigned vc[2][2];
    unsigned ubase = 0u;
#define PG8_AOFF(unit, idx) do { if constexpr (GATHER) { _Pragma("unroll") for (int _h = 0; _h < 2; ++_h) _Pragma("unroll") for (int _i = 0; _i < 2; ++_i) { \
            const unsigned _R = (rcpack >> (16 * _i)) & 0xffu, _C = (rcpack >> (16 * _i + 8)) & 0xffu; vc[_h][_i] = ((unsigned)S.arow((idx), _h * HALF + (int)_R) * (unsigned)K + _C) * 2u; } } \
        else { ubase = (unsigned)(unit).arow0 * (unsigned)K * 2u; vc[0][0] = voffA[0]; vc[0][1] = voffA[1]; vc[1][0] = voffA[0] + hstep; vc[1][1] = voffA[1] + hstep; } } while (0)
    PG8_AOFF(cur, 0);
    f32x4 acc[2][2][4][2];
#pragma unroll
    for (int a_ = 0; a_ < 2; ++a_)
#pragma unroll
        for (int b_ = 0; b_ < 2; ++b_)
#pragma unroll
            for (int m = 0; m < 4; ++m)
#pragma unroll
                for (int n = 0; n < 2; ++n) { f32x4 z_ = {0.f, 0.f, 0.f, 0.f}; if (FP8) asm volatile("" : "+v"(z_)); acc[a_][b_][m][n] = z_; }
    i32x8 At[4], B0[2], B1[2];
    unsigned cB = cur.boff;
    PG8_STAGEB(PG8_SB(0, 0), cB); PG8_STAGEB(PG8_SB(0, 1), cB + hstep); PG8_STAGEA(PG8_SA(0, 0), ubase, vc[0][0], vc[0][1]); PG8_STAGEA(PG8_SA(0, 1), ubase, vc[1][0], vc[1][1]);
    if (wr == 1) PG8_BAR;
    PG8_WAIT_V(2); PG8_BAR;
    PG8_STAGEB(PG8_SB(1, 0), cB + kstep); PG8_STAGEA(PG8_SA(1, 0), ubase + kstep, vc[0][0], vc[0][1]); PG8_STAGEB(PG8_SB(1, 1), cB + hstep + kstep);
    PG8_WAIT_V(6); PG8_BAR;
    for (;;) {
        const bool has_next = S.next(ui + 1, nxt);
        const unsigned nB = has_next ? nxt.boff : cB;
#pragma unroll 1
        for (int t = 0; t < nt; t += 2) {
            const bool last = (t == nt - 2);
            const unsigned k1 = (unsigned)(t + 1) * kstep;
            const unsigned k2 = last ? 0u : (unsigned)(t + 2) * kstep, k3 = k2 + kstep;
            const unsigned b2 = last ? nB : cB + (unsigned)(t + 2) * kstep, b3 = b2 + kstep;
            PG8_LDB(B0, 0, 0); PG8_LDB(B1, 0, 1); PG8_SCHED; PG8_LDA(At, 0, 0); PG8_LSTAGEA(PG8_SA(1, 1), ubase + k1, vc[1][0], vc[1][1]);
            PG8_WAIT_V(8); PG8_WAIT_L(0); PG8_BAR; PG8_MMA(0, 0, At, B0); PG8_MMA(0, 1, At, B1); PG8_BAR; PG8_SCHED;
            if (last && has_next) { PG8_AOFF(nxt, ui + 1); }
            PG8_LDA(At, 0, 1); PG8_LSTAGEB(PG8_SB(0, 0), b2); PG8_LSTAGEB(PG8_SB(0, 1), b2 + hstep); PG8_LSTAGEA(PG8_SA(0, 0), ubase + k2, vc[0][0], vc[0][1]);
            PG8_WAIT_V(8); PG8_WAIT_L(0); PG8_BAR; PG8_MMA(1, 0, At, B0); PG8_MMA(1, 1, At, B1); PG8_BAR; PG8_SCHED;
            PG8_LDB(B0, 1, 0); PG8_LDB(B1, 1, 1); PG8_SCHED; PG8_LDA(At, 1, 0); PG8_LSTAGEA(PG8_SA(0, 1), ubase + k2, vc[1][0], vc[1][1]);
            PG8_WAIT_V(8); PG8_WAIT_L(0); PG8_BAR; PG8_MMA(0, 0, At, B0); PG8_MMA(0, 1, At, B1); PG8_BAR; PG8_SCHED;
            PG8_LDA(At, 1, 1); PG8_LSTAGEB(PG8_SB(1, 0), b3); PG8_LSTAGEB(PG8_SB(1, 1), b3 + hstep); PG8_LSTAGEA(PG8_SA(1, 0), ubase + k3, vc[0][0], vc[0][1]);
            PG8_WAIT_V(8); PG8_WAIT_L(0); PG8_BAR; PG8_MMA(1, 0, At, B0); PG8_MMA(1, 1, At, B1); PG8_BAR; PG8_SCHED;
        }
        if (wr == 0) PG8_BAR;
        E(acc, cur, wr, wc, fr, fq);
        if (!has_next) break;
#pragma unroll
        for (int a_ = 0; a_ < 2; ++a_)
#pragma unroll
            for (int b_ = 0; b_ < 2; ++b_)
#pragma unroll
                for (int m = 0; m < 4; ++m)
#pragma unroll
                    for (int n = 0; n < 2; ++n) { f32x4 z_ = {0.f, 0.f, 0.f, 0.f}; if (FP8) asm volatile("" : "+v"(z_)); acc[a_][b_][m][n] = z_; }
        cur = nxt; cB = nB; ++ui;
        if (wr == 1) PG8_BAR;
    }
    PG8_WAIT_V(0);
    PG8_BAR;
#undef PG8_SA
#undef PG8_SB
#undef PG8_STAGEA
#undef PG8_STAGEB
#undef PG8_LSTAGEA
#undef PG8_LSTAGEB
#undef PG8_LDA
#undef PG8_LDB
#undef PG8_MMA
#undef PG8_LOH
#undef PG8_HIH
#undef PG8_WAIT_V
#undef PG8_WAIT_L
#undef PG8_BAR
#undef PG8_SCHED
#undef PG8_AOFF
}

struct EpiBf16 {
    static constexpr bool PERM = true;
    bf16_t* O; int ldc;
    DI void operator()(const f32x4 (&acc)[2][2][4][2], const Unit& u, int wr, int wc, int fr, int fq) const {
        const int row0 = u.orow0 + wr * 64 + fr, col0 = u.pn * BM + wc * 32 + 8 * fq;
#pragma unroll
        for (int ai = 0; ai < 2; ++ai)
#pragma unroll
            for (int m = 0; m < 4; ++m) { bf16_t* rowp = O + (size_t)(row0 + ai * HALF + m * 16) * ldc + col0;
#pragma unroll
                for (int bj = 0; bj < 2; ++bj) { const f32x4 v0 = acc[ai][bj][m][0], v1 = acc[ai][bj][m][1];
                    u32x4 w; w[0] = pk2(v0[0], v0[1]); w[1] = pk2(v0[2], v0[3]); w[2] = pk2(v1[0], v1[1]); w[3] = pk2(v1[2], v1[3]);
                    *(u32x4*)(rowp + bj * HALF) = w; } }
    }
};
struct EpiGlu {
    static constexpr bool PERM = true;
    const bf16_t* YG; bf16_t* AR;
    DI void operator()(const f32x4 (&acc)[2][2][4][2], const Unit& u, int wr, int wc, int fr, int fq) const {
        const int row0 = u.orow0 + wr * 64 + fr, col0 = u.pn * BM + wc * 32 + 8 * fq;
#pragma unroll
        for (int ai = 0; ai < 2; ++ai)
#pragma unroll
            for (int m = 0; m < 4; ++m) { const size_t r = (size_t)(row0 + ai * HALF + m * 16);
#pragma unroll
                for (int bj = 0; bj < 2; ++bj) { const f32x4 v0 = acc[ai][bj][m][0], v1 = acc[ai][bj][m][1];
                    const u32x4 y = *(const u32x4*)(YG + r * 512 + col0 + bj * HALF);
                    u32x4 w; w[0] = pk2(bflo(y[0]) * sigmoidf_(v0[0]), bfhi(y[0]) * sigmoidf_(v0[1])); w[1] = pk2(bflo(y[1]) * sigmoidf_(v0[2]), bfhi(y[1]) * sigmoidf_(v0[3]));
                    w[2] = pk2(bflo(y[2]) * sigmoidf_(v1[0]), bfhi(y[2]) * sigmoidf_(v1[1])); w[3] = pk2(bflo(y[3]) * sigmoidf_(v1[2]), bfhi(y[3]) * sigmoidf_(v1[3]));
                    *(u32x4*)(AR + r * 1024 + col0 + bj * HALF) = w; } }
    }
};
template <bool XIN16>
struct EpiResid {
    static constexpr bool PERM = true;
    const float* xlat; const float* xctx; bf16_t* XS; const float* gatev;
    DI void operator()(const f32x4 (&acc)[2][2][4][2], const Unit& u, int wr, int wc, int fr, int fq) const {
        const int row0 = u.orow0 + wr * 64 + fr, col0 = u.pn * BM + wc * 32 + 8 * fq;
        const int s = row_s(u.orow0);
        f32x4 gv[2][2];
#pragma unroll
        for (int bj = 0; bj < 2; ++bj)
#pragma unroll
            for (int n = 0; n < 2; ++n) gv[bj][n] = *(const f32x4*)(gatev + (size_t)s * 6144 + col0 + bj * HALF + n * 4);
#pragma unroll
        for (int ai = 0; ai < 2; ++ai)
#pragma unroll
            for (int m = 0; m < 4; ++m) { const int r = row0 + ai * HALF + m * 16;
                bf16_t* xo = XS + (size_t)r * 1024 + col0;
#pragma unroll
                for (int bj = 0; bj < 2; ++bj) {
                    f32x4 x0, x1;
                    if (XIN16) { const u32x4 w = *(const u32x4*)(xo + bj * HALF); x0 = (f32x4){bflo(w[0]), bfhi(w[0]), bflo(w[1]), bfhi(w[1])}; x1 = (f32x4){bflo(w[2]), bfhi(w[2]), bflo(w[3]), bfhi(w[3])}; }
                    else { const float* xin = (r < NLAT ? xlat + (size_t)r * 1024 : xctx + (size_t)(r - NLAT) * 1024) + col0 + bj * HALF; x0 = *(const f32x4*)xin; x1 = *(const f32x4*)(xin + 4); }
                    x0 += gv[bj][0] * acc[ai][bj][m][0]; x1 += gv[bj][1] * acc[ai][bj][m][1];
                    u32x4 o; o[0] = pk2(x0[0], x0[1]); o[1] = pk2(x0[2], x0[3]); o[2] = pk2(x1[0], x1[1]); o[3] = pk2(x1[2], x1[3]);
                    *(u32x4*)(xo + bj * HALF) = o; }
            }
    }
};
struct EpiSwiglu {
    static constexpr bool PERM = true;
    unsigned char* ACT; const float* b1;
    DI void operator()(const f32x4 (&acc)[2][2][4][2], const Unit& u, int wr, int wc, int fr, int fq) const {
        const int row0 = u.orow0 + wr * 64 + fr, col0 = u.pn * HALF + wc * 32 + 8 * fq;
        const float* bg = b1 + (size_t)u.e * 2048 + col0; const float* bl = bg + 1024;
        const f32x4 bg0 = *(const f32x4*)bg, bg1 = *(const f32x4*)(bg + 4), bl0 = *(const f32x4*)bl, bl1 = *(const f32x4*)(bl + 4);
#pragma unroll
        for (int ai = 0; ai < 2; ++ai)
#pragma unroll
            for (int m = 0; m < 4; ++m) { const size_t r = (size_t)(row0 + ai * HALF + m * 16);
                u32x2 w;
#pragma unroll
                for (int n = 0; n < 2; ++n) {
                    const f32x4 seven = {7.0f, 7.0f, 7.0f, 7.0f};
                    const f32x4 xg = __builtin_elementwise_min(acc[ai][0][m][n] + (n ? bg1 : bg0), seven);
                    const f32x4 xl = __builtin_elementwise_min(__builtin_elementwise_max(acc[ai][1][m][n] + (n ? bl1 : bl0), -seven), seven);
                    const f32x4 ea = xg * (-1.702f * 1.4426950408889634f);
                    f32x4 d = {ex2(ea[0]), ex2(ea[1]), ex2(ea[2]), ex2(ea[3])}; d += 1.0f;
                    const f32x4 rc = {__builtin_amdgcn_rcpf(d[0]), __builtin_amdgcn_rcpf(d[1]), __builtin_amdgcn_rcpf(d[2]), __builtin_amdgcn_rcpf(d[3])};
                    const f32x4 o = (xg * rc) * (xl * 8.0f + 8.0f);
                    w[n] = pk4_fp8(o[0], o[1], o[2], o[3]); }
                *(u32x2*)(ACT + r * 1024 + col0) = w; }
    }
};
struct EpiY2 {
    static constexpr bool PERM = true;
    bf16_t* Y2; const float* b2;
    DI void operator()(const f32x4 (&acc)[2][2][4][2], const Unit& u, int wr, int wc, int fr, int fq) const {
        const int row0 = u.orow0 + wr * 64 + fr, col0 = u.pn * BM + wc * 32 + 8 * fq;
        f32x4 bv[2][2];
#pragma unroll
        for (int bj = 0; bj < 2; ++bj)
#pragma unroll
            for (int n = 0; n < 2; ++n) bv[bj][n] = *(const f32x4*)(b2 + (size_t)u.e * 1024 + col0 + bj * HALF + 4 * n);
#pragma unroll
        for (int ai = 0; ai < 2; ++ai)
#pragma unroll
            for (int m = 0; m < 4; ++m) {
#pragma unroll
                for (int bj = 0; bj < 2; ++bj) { const f32x4 v0 = (acc[ai][bj][m][0] + bv[bj][0]) * 16.0f, v1 = (acc[ai][bj][m][1] + bv[bj][1]) * 16.0f;
                    u32x2 w; w[0] = pk4_fp8(v0[0], v0[1], v0[2], v0[3]); w[1] = pk4_fp8(v1[0], v1[1], v1[2], v1[3]);
                    *(u32x2*)((unsigned char*)Y2 + (size_t)(row0 + ai * HALF + m * 16) * 1024 + col0 + bj * HALF) = w; } }
    }
};
struct EpiY2NoBias {
    static constexpr bool PERM = true;
    bf16_t* Y2;
    DI void operator()(const f32x4 (&acc)[2][2][4][2], const Unit& u, int wr, int wc, int fr, int fq) const {
        const int row0 = u.orow0 + wr * 64 + fr, col0 = u.pn * BM + wc * 32 + 8 * fq;
#pragma unroll
        for (int ai = 0; ai < 2; ++ai)
#pragma unroll
            for (int m = 0; m < 4; ++m) { bf16_t* rowp = Y2 + (size_t)(row0 + ai * HALF + m * 16) * 1024 + col0;
#pragma unroll
                for (int bj = 0; bj < 2; ++bj) { const f32x4 v0 = acc[ai][bj][m][0], v1 = acc[ai][bj][m][1];
                    u32x4 w; w[0] = pk2(v0[0], v0[1]); w[1] = pk2(v0[2], v0[3]); w[2] = pk2(v1[0], v1[1]); w[3] = pk2(v1[2], v1[3]);
                    *(u32x4*)(rowp + bj * HALF) = w; } }
    }
};
struct EpiSink {
    static constexpr bool PERM = true;
    DI void operator()(const f32x4 (&acc)[2][2][4][2], const Unit&, int, int, int, int) const {
#pragma unroll
        for (int ai = 0; ai < 2; ++ai)
#pragma unroll
            for (int bj = 0; bj < 2; ++bj)
#pragma unroll
                for (int m = 0; m < 4; ++m)
#pragma unroll
                    for (int n = 0; n < 2; ++n) asm volatile("" :: "v"(acc[ai][bj][m][n]));
    }
};
}

template <int WHICH>
DI void moe_gemm(const Args& a, LAS unsigned char* lds, int layer) {
    const int tid = threadIdx.x; unsigned char* ws = a.ws;
    LAS int* tile_e = (LAS int*)(lds + pg8::STAGE_BYTES); LAS int* tile_s0 = tile_e + 576; LAS int* misc = tile_s0 + 576; LAS int* rowtab = misc + 64;
    const int* etot = (const int*)(ws + WS_ETOT);
    if (tid < 32) misc[32 + tid] = (ld_i(etot + tid) + 255) >> 8;
    __syncthreads();
    if (tid < 32) { int pre = 0; for (int e2 = 0; e2 < tid; ++e2) pre += misc[32 + e2]; const int n = misc[32 + tid];
        for (int t = 0; t < n; ++t) { tile_e[pre + t] = tid; tile_s0[pre + t] = 256 * (pre + t); }
        if (tid == 31) misc[0] = pre + n; }
    __syncthreads();
    const int ntile = misc[0];
    constexpr int NPN = (WHICH == 1) ? 8 : 4;
    pg8::MoeOrder S; S.ntile = ntile; S.NPN = NPN; S.G = gridDim.x; S.c = blockIdx.x; S.tile_e = tile_e; S.tile_s0 = tile_s0; S.rowtab = rowtab; S.btile = 256u * 1024u;
    if (WHICH == 1) {
        const int* stok = (const int*)(ws + WS_STOK);
        { int nr = 0; for (;; ++nr) { int pn_; if (S.tile_of(nr, pn_) < 0) break; }
          for (int f = tid; f < nr * 256; f += NTHR) { int pn_; const int t = S.tile_of(f >> 8, pn_); rowtab[f] = ld_i(stok + 256 * t + (f & 255)); } }
        __syncthreads();
        S.W = ws + WS_W1 + (size_t)layer * 32 * 2048 * 1024; S.wexp = 2048u * 1024u;
        pg8::EpiSwiglu E{ws + WS_ACT, a.in[I_B1] + (size_t)layer * 32 * 2048};
        pg8::gemm_phase<true, true, 127, 121>(lds, ws + WS_H, 512, S, E);
    } else {
        S.W = ws + WS_W2 + (size_t)layer * 32 * 1024 * 1024; S.wexp = 1024u * 1024u;
        for (int i = 0;; ++i) { int pn_; const int t = S.tile_of(i, pn_); if (t < 0) break; const int s0 = tile_s0[t]; if (tid < 256) rowtab[i * 256 + tid] = s0 + tid; }
        __syncthreads();
        pg8::EpiY2 E{(bf16_t*)(ws + WS_Y2), a.in[I_B2] + (size_t)layer * 32 * 1024};
        pg8::gemm_phase<true, true, 124, 121>(lds, ws + WS_ACT, 512, S, E);
    }
    __syncthreads();
}

constexpr size_t WS_Y2B = WS_END;
template <int VAR>
DI void moe_gemm2_probe(const Args& a, LAS unsigned char* lds, int layer) {
    const int tid = threadIdx.x; unsigned char* ws = a.ws;
    LAS int* tile_e = (LAS int*)(lds + pg8::STAGE_BYTES); LAS int* tile_s0 = tile_e + 576; LAS int* misc = tile_s0 + 576; LAS int* rowtab = misc + 64;
    const int* etot = (const int*)(ws + WS_ETOT);
    if (tid < 32) misc[32 + tid] = (ld_i(etot + tid) + 255) >> 8;
    __syncthreads();
    if (tid < 32) { int pre = 0; for (int e2 = 0; e2 < tid; ++e2) pre += misc[32 + e2]; const int n = misc[32 + tid];
        for (int t = 0; t < n; ++t) { tile_e[pre + t] = tid; tile_s0[pre + t] = 256 * (pre + t); }
        if (tid == 31) misc[0] = pre + n; }
    __syncthreads();
    const int ntile = misc[0];
    constexpr int NPN = 4;
    pg8::MoeOrder S; S.ntile = ntile; S.NPN = NPN; S.G = gridDim.x; S.c = blockIdx.x; S.tile_e = tile_e; S.tile_s0 = tile_s0; S.rowtab = rowtab; S.btile = 256u * 1024u;
    S.W = ws + WS_W2 + (size_t)layer * 32 * 1024 * 1024; S.wexp = (VAR == 4 || VAR == 5) ? 0u : 1024u * 1024u;
    for (int i = 0;; ++i) { int pn_; const int t = S.tile_of(i, pn_); if (t < 0) break; const int s0 = tile_s0[t]; if (tid < 256) rowtab[i * 256 + tid] = (VAR == 3 || VAR == 5) ? tid : s0 + tid; }
    __syncthreads();
    if (VAR == 2) { pg8::EpiY2NoBias E{(bf16_t*)(ws + WS_Y2B)}; pg8::gemm_phase<true, true, 124, 121>(lds, ws + WS_ACT, 512, S, E); }
    else if (VAR == 6) { pg8::EpiSink E{}; pg8::gemm_phase<true, true, 124, 121>(lds, ws + WS_ACT, 512, S, E); }
    else if (VAR == 7) { pg8::EpiSink E{}; pg8::gemm_phase<true, true, 124, 121, 1>(lds, ws + WS_ACT, 512, S, E); }
    else if (VAR == 8) { pg8::EpiSink E{}; pg8::gemm_phase<true, true, 124, 121, 2>(lds, ws + WS_ACT, 512, S, E); }
    else { pg8::EpiY2 E{(bf16_t*)(ws + WS_Y2B), a.in[I_B2] + (size_t)layer * 32 * 1024}; pg8::gemm_phase<true, true, 124, 121>(lds, ws + WS_ACT, 512, S, E); }
    __syncthreads();
}

constexpr int S5_ROWB = 272;
constexpr int S5_WAVE_LDS = 32 * S5_ROWB + 4096;
template <bool OUT>
DI void s5_item_old(const Args& a, LAS unsigned char* wl, int b, int g, int mc, int lane) {
    unsigned char* ws = a.ws;
    const bf16_t* P = (const bf16_t*)(ws + WS_P);
    const int row0 = chunk_row0(b, mc);
    const int h = lane >> 5, cl = lane & 31;
    LAS unsigned char* ytmp = wl + 32 * S5_ROWB;
    const int i0 = 4 * (lane >> 4);
#pragma unroll 1
    for (int dr = 0; dr < 2; ++dr) {
        const f32x4 t = ((const f32x4*)(ws + WS_S5A))[(dr * 32 + g) * 64 + lane]; const float are = t[0], aim = t[1];
        bf16x8 BF[4], CF[4];
#pragma unroll
        for (int m = 0; m < 4; ++m) BF[m] = ((const bf16x8*)(ws + WS_S5BF))[((dr * 32 + g) * 4 + m) * 64 + lane];
        float sre = 0.f, sim = 0.f;
        if (OUT) {
#pragma unroll
            for (int ks = 0; ks < 4; ++ks) CF[ks] = ((const bf16x8*)(ws + WS_S5CF))[((dr * 32 + g) * 4 + ks) * 64 + lane];
            const f32x2 h0 = ((const f32x2*)(ws + WS_S5H))[((((size_t)b * 2 + dr) * 32 + g) * 130 + mc) * 64 + lane]; sre = h0[0]; sim = h0[1];
        }
#pragma unroll 1
        for (int jj = 0; jj < 4; ++jj) {
            const int sb = dr ? 3 - jj : jj;
            const bf16x8 uf = *(const bf16x8*)(P + (size_t)(row0 + 32 * sb + cl) * 2560 + 16 * g + 8 * h);
            u32x2 uwp[2] = {{0u, 0u}, {0u, 0u}};
            if (OUT && dr == 0) {
#pragma unroll
                for (int tq = 0; tq < 2; ++tq) uwp[tq] = *(const u32x2*)(P + (size_t)(row0 + 32 * sb + 16 * tq + (lane & 15)) * 2560 + 16 * g + i0);
            }
#pragma unroll
            for (int half = 0; half < 2; ++half) {
                const f32x16 dre = MFMA32(uf, BF[2 * half], zero16()), dim = MFMA32(uf, BF[2 * half + 1], zero16());
#pragma unroll
                for (int rr = 0; rr < 16; ++rr) *(LAS unsigned*)(wl + crow(rr, h) * S5_ROWB + (32 * half + cl) * 4) = pk2(dre[rr], dim[rr]);
            }
            LDS_WAIT();
            {
                const int tstep = dr ? -S5_ROWB : S5_ROWB;
                LAS unsigned char* p0 = wl + (dr ? 31 * S5_ROWB : 0) + lane * 4;
                unsigned bu[32];
#pragma unroll
                for (int tt = 0; tt < 32; ++tt) bu[tt] = *(LAS unsigned*)(p0 + tt * tstep);
#pragma unroll
                for (int tt = 0; tt < 32; ++tt) {
                    const float nre = are * sre - aim * sim + bflo(bu[tt]), nim = are * sim + aim * sre + bfhi(bu[tt]); sre = nre; sim = nim;
                    if (OUT) *(LAS unsigned*)(p0 + tt * tstep) = pk2(sre, sim);
                }
            }
            if (OUT) {
                LDS_WAIT();
#pragma unroll
                for (int tq = 0; tq < 2; ++tq) {
                    f32x4 y = {0.f, 0.f, 0.f, 0.f};
#pragma unroll
                    for (int ks = 0; ks < 4; ++ks) {
                        const bf16x8 bfr = *(const LAS bf16x8*)(wl + (16 * tq + (lane & 15)) * S5_ROWB + (32 * ks + 8 * (lane >> 4)) * 2);
                        y = MFMA16(CF[ks], bfr, y);
                    }
                    const int tok = 32 * sb + 16 * tq + (lane & 15);
                    const size_t r = (size_t)(row0 + tok);
                    LAS u32x2* yt = (LAS u32x2*)(ytmp + tok * 32 + i0 * 2);
                    if (dr == 0) {
                        const f32x4 dsk = *(const f32x4*)(a.in[I_S5D] + 16 * g + i0);
                        const u32x2 uw = uwp[tq];
                        u32x2 o; o[0] = pk2(y[0] + bflo(uw[0]) * dsk[0], y[1] + bfhi(uw[0]) * dsk[1]); o[1] = pk2(y[2] + bflo(uw[1]) * dsk[2], y[3] + bfhi(uw[1]) * dsk[3]);
                        *yt = o;
                    } else {
                        const u32x2 pw = *yt;
                        float yy[4] = {y[0] + bflo(pw[0]), y[1] + bfhi(pw[0]), y[2] + bflo(pw[1]), y[3] + bfhi(pw[1])};
#pragma unroll
                        for (int q = 0; q < 4; ++q) { const float x = yy[q], z = 0.7978845608f * (x + 0.044715f * x * x * x); yy[q] = x * __builtin_amdgcn_rcpf(1.0f + __expf(-2.0f * z)); }
                        u32x2 o; o[0] = pk2(yy[0], yy[1]); o[1] = pk2(yy[2], yy[3]);
                        *(u32x2*)((bf16_t*)(ws + WS_YG) + r * 512 + 16 * g + i0) = o;
                    }
                }
                LDS_WAIT();
            }
        }
        if (!OUT) ((f32x2*)(ws + WS_S5E))[((((size_t)b * 2 + dr) * 32 + g) * 130 + mc) * 64 + lane] = (f32x2){sre, sim};
    }
}


template <bool OUT, int DR>
DI void s5_dir(const Args& a, LAS unsigned char* wl, int b, int g, int mc, int lane) {
    unsigned char* ws = a.ws;
    const bf16_t* P = (const bf16_t*)(ws + WS_P);
    const int row0 = chunk_row0(b, mc);
    const int h = lane >> 5, cl = lane & 31;
    LAS unsigned char* ytmp = wl + 32 * S5_ROWB;
    const int i0 = 4 * (lane >> 4);
    const f32x4 t4 = ((const f32x4*)(ws + WS_S5A))[(DR * 32 + g) * 64 + lane]; const float are = t4[0], aim = t4[1];
    bf16x8 BF[4], CF[4];
#pragma unroll
    for (int m = 0; m < 4; ++m) BF[m] = ((const bf16x8*)(ws + WS_S5BF))[((DR * 32 + g) * 4 + m) * 64 + lane];
    float sre = 0.f, sim = 0.f;
    if (OUT) {
#pragma unroll
        for (int ks = 0; ks < 4; ++ks) CF[ks] = ((const bf16x8*)(ws + WS_S5CF))[((DR * 32 + g) * 4 + ks) * 64 + lane];
        const f32x2 h0 = ((const f32x2*)(ws + WS_S5H))[((((size_t)b * 2 + DR) * 32 + g) * 130 + mc) * 64 + lane]; sre = h0[0]; sim = h0[1];
    }
#pragma unroll 1
    for (int jj = 0; jj < 4; ++jj) {
        const int sb = DR ? 3 - jj : jj;
        const bf16x8 uf = *(const bf16x8*)(P + (size_t)(row0 + 32 * sb + cl) * 2560 + 16 * g + 8 * h);
        f32x16 xre = MFMA32(uf, BF[0], zero16()), xim = MFMA32(uf, BF[1], zero16()), yre = MFMA32(uf, BF[2], zero16()), yim = MFMA32(uf, BF[3], zero16());
        asm volatile("s_nop 15\n\ts_nop 15\n\ts_nop 15\n\ts_nop 15\n\ts_nop 15\n\ts_nop 15" : "+v"(xre), "+v"(xim), "+v"(yre), "+v"(yim));
#pragma unroll
        for (int rr = 0; rr < 16; ++rr) {
            const float xa = xre[rr], ya = yre[rr], xb = xim[rr], yb = yim[rr];
            auto r1 = __builtin_amdgcn_permlane32_swap(__float_as_uint(xa), __float_as_uint(ya), false, false);
            xre[rr] = __uint_as_float(r1[0]); yre[rr] = __uint_as_float(r1[1]);
            auto r2 = __builtin_amdgcn_permlane32_swap(__float_as_uint(xb), __float_as_uint(yb), false, false);
            xim[rr] = __uint_as_float(r2[0]); yim[rr] = __uint_as_float(r2[1]);
        }
#pragma unroll
        for (int tt = 0; tt < 32; ++tt) {
            const int tk = DR ? 31 - tt : tt, rr = (tk & 3) + 4 * (tk >> 3);
            const float bre = ((tk >> 2) & 1) ? yre[rr] : xre[rr], bim = ((tk >> 2) & 1) ? yim[rr] : xim[rr];
            const float nre = are * sre - aim * sim + bre, nim = are * sim + aim * sre + bim; sre = nre; sim = nim;
            if (OUT) *(LAS unsigned*)(wl + tk * S5_ROWB + lane * 4) = pk2(sre, sim);
        }
        if (OUT) {
            LDS_WAIT();
#pragma unroll
            for (int tq = 0; tq < 2; ++tq) {
                f32x4 y = {0.f, 0.f, 0.f, 0.f};
#pragma unroll
                for (int ks = 0; ks < 4; ++ks) {
                    const bf16x8 bfr = *(const LAS bf16x8*)(wl + (16 * tq + (lane & 15)) * S5_ROWB + (32 * ks + 8 * (lane >> 4)) * 2);
                    y = MFMA16(CF[ks], bfr, y);
                }
                const int tok = 32 * sb + 16 * tq + (lane & 15);
                const size_t r = (size_t)(row0 + tok);
                LAS u32x2* yt = (LAS u32x2*)(ytmp + tok * 32 + i0 * 2);
                if (DR == 0) {
                    const f32x4 dsk = *(const f32x4*)(a.in[I_S5D] + 16 * g + i0);
                    const u32x2 uw = *(const u32x2*)(P + r * 2560 + 16 * g + i0);
                    u32x2 o; o[0] = pk2(y[0] + bflo(uw[0]) * dsk[0], y[1] + bfhi(uw[0]) * dsk[1]); o[1] = pk2(y[2] + bflo(uw[1]) * dsk[2], y[3] + bfhi(uw[1]) * dsk[3]);
                    *yt = o;
                } else {
                    const u32x2 pw = *yt;
                    float yy[4] = {y[0] + bflo(pw[0]), y[1] + bfhi(pw[0]), y[2] + bflo(pw[1]), y[3] + bfhi(pw[1])};
#pragma unroll
                    for (int q = 0; q < 4; ++q) { const float x = yy[q], z = 0.7978845608f * (x + 0.044715f * x * x * x); yy[q] = x * __builtin_amdgcn_rcpf(1.0f + __expf(-2.0f * z)); }
                    u32x2 o; o[0] = pk2(yy[0], yy[1]); o[1] = pk2(yy[2], yy[3]);
                    *(u32x2*)((bf16_t*)(ws + WS_YG) + r * 512 + 16 * g + i0) = o;
                }
            }
            LDS_WAIT();
        }
    }
    if (!OUT) ((f32x2*)(ws + WS_S5E))[((((size_t)b * 2 + DR) * 32 + g) * 130 + mc) * 64 + lane] = (f32x2){sre, sim};
}
template <bool OUT>
DI void s5_item(const Args& a, LAS unsigned char* wl, int b, int g, int mc, int lane) {
    s5_dir<OUT, 0>(a, wl, b, g, mc, lane);
    asm volatile("" ::: "memory");
    s5_dir<OUT, 1>(a, wl, b, g, mc, lane);
}

DI void rope8(const u32x4& x1, const u32x4& x2, const f32x2* tab  , int f0, float sc, float* o1, float* o2) {
#pragma unroll
    for (int q = 0; q < 4; ++q) {
        const float a0 = bflo(x1[q]), a1 = bfhi(x1[q]), b0 = bflo(x2[q]), b1 = bfhi(x2[q]);
        if (tab) { const f32x2 c0 = tab[f0 + 2 * q], c1 = tab[f0 + 2 * q + 1];
            o1[2 * q] = (a0 * c0[0] - b0 * c0[1]) * sc; o2[2 * q] = (a0 * c0[1] + b0 * c0[0]) * sc;
            o1[2 * q + 1] = (a1 * c1[0] - b1 * c1[1]) * sc; o2[2 * q + 1] = (a1 * c1[1] + b1 * c1[0]) * sc;
        } else { o1[2 * q] = a0 * sc; o1[2 * q + 1] = a1 * sc; o2[2 * q] = b0 * sc; o2[2 * q + 1] = b1 * sc; }
    }
}
DI void rope8u(const u32x4& x1, const u32x4& x2, const f32x2* tab, int f0, float sc, float* o1, float* o2) {
    f32x4 cs[4];
#pragma unroll
    for (int q = 0; q < 4; ++q) cs[q] = *(const f32x4*)(tab + f0 + 2 * q);
#pragma unroll
    for (int q = 0; q < 4; ++q) {
        const float a0 = bflo(x1[q]), a1 = bfhi(x1[q]), b0 = bflo(x2[q]), b1 = bfhi(x2[q]);
        o1[2 * q] = (a0 * cs[q][0] - b0 * cs[q][1]) * sc; o2[2 * q] = (a0 * cs[q][1] + b0 * cs[q][0]) * sc;
        o1[2 * q + 1] = (a1 * cs[q][2] - b1 * cs[q][3]) * sc; o2[2 * q + 1] = (a1 * cs[q][3] + b1 * cs[q][2]) * sc;
    }
}
DI u32x4 pack8f(const float* o, float w) { u32x4 r; r[0] = pk2(o[0] * w, o[1] * w); r[1] = pk2(o[2] * w, o[3] * w); r[2] = pk2(o[4] * w, o[5] * w); r[3] = pk2(o[6] * w, o[7] * w); return r; }

template <int HI>
DI void tr_read4(unsigned base, bf16x8 (&f)[4]) {
    s16x4 r0, r1, r2, r3, r4, r5, r6, r7;
    asm volatile("ds_read_b64_tr_b16 %0, %8 offset:%9\n\tds_read_b64_tr_b16 %1, %8 offset:%10\n\tds_read_b64_tr_b16 %2, %8 offset:%11\n\tds_read_b64_tr_b16 %3, %8 offset:%12\n\t"
                 "ds_read_b64_tr_b16 %4, %8 offset:%13\n\tds_read_b64_tr_b16 %5, %8 offset:%14\n\tds_read_b64_tr_b16 %6, %8 offset:%15\n\tds_read_b64_tr_b16 %7, %8 offset:%16\n\ts_waitcnt lgkmcnt(0)"
                 : "=&v"(r0), "=&v"(r1), "=&v"(r2), "=&v"(r3), "=&v"(r4), "=&v"(r5), "=&v"(r6), "=&v"(r7)
                 : "v"(base), "i"(0), "i"(HI), "i"(64), "i"(HI + 64), "i"(128), "i"(HI + 128), "i"(192), "i"(HI + 192) : "memory");
    f[0] = __builtin_shufflevector(r0, r1, 0, 1, 2, 3, 4, 5, 6, 7); f[1] = __builtin_shufflevector(r2, r3, 0, 1, 2, 3, 4, 5, 6, 7);
    f[2] = __builtin_shufflevector(r4, r5, 0, 1, 2, 3, 4, 5, 6, 7); f[3] = __builtin_shufflevector(r6, r7, 0, 1, 2, 3, 4, 5, 6, 7);
}
struct R1Raw { u32x4 v[4], k1[2], k2[2]; };
DI void ret1_load(const Args& a, int q, R1Raw& raw) {
    const int tid = threadIdx.x; const bf16_t* P = (const bf16_t*)(a.ws + WS_P);
    const int b = q / 520, r = q % 520, hd = r / 130, mc = r % 130, row0 = chunk_row0(b, mc);
#pragma unroll
    for (int i = 0; i < 4; ++i) { const int c = tid + 512 * i, tok = c >> 4, ch = c & 15; raw.v[i] = *(const u32x4*)(P + (size_t)(row0 + tok) * 2560 + 1536 + 128 * hd + 8 * ch); }
#pragma unroll
    for (int i = 0; i < 2; ++i) { const int it = tid + 512 * i, tok = it >> 3, pr = it & 7, dk0 = (pr & 3) * 8 + (pr >> 2) * 64;
        const bf16_t* src = P + (size_t)(row0 + tok) * 2560 + 1024 + 128 * hd + dk0; raw.k1[i] = *(const u32x4*)src; raw.k2[i] = *(const u32x4*)(src + 32); }
}
DI void ret1_loop(const Args& a, LAS unsigned char* lds) {
    const int tid = threadIdx.x, lane = tid & 63, wave = tid >> 6;
    unsigned char* ws = a.ws;
    LAS unsigned char* Vl = lds; LAS unsigned char* Kf = lds + 32768; LAS unsigned char* Kb = lds + 65536;
    const int dvt = wave & 3, dir = wave >> 2;
    const int h = lane >> 5, i16 = lane & 15, qq = i16 >> 2, p = i16 & 3, blk = (lane >> 4) & 1;
    const unsigned vbase = (unsigned)(size_t)Vl, kbase = (unsigned)(size_t)(dir ? Kb : Kf);
    R1Raw raw;
    int q = blockIdx.x;
    if (q < 1040) ret1_load(a, q, raw);
#pragma unroll 1
    for (; q < 1040; q += gridDim.x) {
        const int b = q / 520, r = q % 520, hd = r / 130, mc = r % 130; const bool lat = mc < 128;
        const float lgf = a.in[I_DECAY][hd] * 1.4426950408889634f, lgb = a.in[I_DECAY][4 + hd] * 1.4426950408889634f;
        __syncthreads();
#pragma unroll
        for (int i = 0; i < 4; ++i) { const int c = tid + 512 * i, tok = c >> 4, ch = c & 15; *(LAS u32x4*)(Vl + tok * 256 + ch * 16) = raw.v[i]; }
#pragma unroll
        for (int i = 0; i < 2; ++i) { const int it = tid + 512 * i, tok = it >> 3, pr = it & 7, dk0 = (pr & 3) * 8 + (pr >> 2) * 64;
            const int t = mc * 128 + tok, pos = (pr >> 2) ? (t & 63) : (t >> 6);
            const f32x2* tab = lat ? (const f32x2*)(ws + WS_ROPE) + pos * 32 : nullptr;
            float o1[8], o2[8]; rope8(raw.k1[i], raw.k2[i], tab, (pr & 3) * 8, 0.08838834764831845f, o1, o2);
            const float wf = ex2(lgf * (float)(127 - tok)), wb = ex2(lgb * (float)tok);
            *(LAS u32x4*)(Kf + tok * 256 + dk0 * 2) = pack8f(o1, wf); *(LAS u32x4*)(Kf + tok * 256 + (dk0 + 32) * 2) = pack8f(o2, wf);
            *(LAS u32x4*)(Kb + tok * 256 + dk0 * 2) = pack8f(o1, wb); *(LAS u32x4*)(Kb + tok * 256 + (dk0 + 32) * 2) = pack8f(o2, wb); }
        __syncthreads();
        if (q + (int)gridDim.x < 1040) ret1_load(a, q + gridDim.x, raw);
        f32x16 acc[4];
#pragma unroll
        for (int i = 0; i < 4; ++i) acc[i] = zero16();
#pragma unroll 2
        for (int ks = 0; ks < 8; ++ks) {
            const unsigned rlo = (unsigned)(16 * ks + 8 * h + qq) * 256u, rhi = rlo + 4u * 256u, cofs = (unsigned)(16 * blk + 4 * p) * 2u;
            const bf16x8 af = tr_read2(vbase + rlo + 64u * dvt + cofs, vbase + rhi + 64u * dvt + cofs);
            bf16x8 bfv[4]; tr_read4<1024>(kbase + rlo + cofs, bfv);
#pragma unroll
            for (int dkt = 0; dkt < 4; ++dkt) acc[dkt] = MFMA32(af, bfv[dkt], acc[dkt]);
        }
        unsigned* out = (unsigned*)(ws + WS_KVL) + ((((size_t)b * 4 + hd) * 2 + dir) * 130 + mc) * 8192;
#pragma unroll
        for (int dkt = 0; dkt < 4; ++dkt)
#pragma unroll
            for (int rr = 0; rr < 16; rr += 2) out[(size_t)((32 * dvt + crow(rr, h)) >> 1) * 128 + 32 * dkt + (lane & 31)] = pk2(acc[dkt][rr], acc[dkt][rr + 1]);
    }
    __syncthreads();
}

DI void ret3_stage(const Args& a, LAS unsigned char* li, int b, int hd, int mc, int lt) {
    unsigned char* ws = a.ws; const bf16_t* P = (const bf16_t*)(ws + WS_P);
    const int row0 = chunk_row0(b, mc); const bool lat = mc < 128;
#pragma unroll
    for (int i = 0; i < 8; ++i) { const int c = lt + 256 * i, tok = c >> 4, ch = c & 15;
        *(LAS u32x4*)(li + 32768 + tok * 256 + ch * 16) = *(const u32x4*)(P + (size_t)(row0 + tok) * 2560 + 1536 + 128 * hd + 8 * ch); }
#pragma unroll
    for (int i = 0; i < 4; ++i) { const int it = lt + 256 * i, tok = it >> 3, pr = it & 7, dk0 = (pr & 3) * 8 + (pr >> 2) * 64;
        const bf16_t* src = P + (size_t)(row0 + tok) * 2560 + 1024 + 128 * hd + dk0;
        const u32x4 x1 = *(const u32x4*)src, x2 = *(const u32x4*)(src + 32);
        const int t = mc * 128 + tok, pos = (pr >> 2) ? (t & 63) : (t >> 6);
        const f32x2* tab = (const f32x2*)(ws + WS_ROPE) + (lat ? pos : 0) * 32;
        float o1[8], o2[8]; rope8u(x1, x2, tab, (pr & 3) * 8, 0.08838834764831845f, o1, o2);
        *(LAS u32x4*)(li + tok * 256 + dk0 * 2) = pack8f(o1, 1.0f); *(LAS u32x4*)(li + tok * 256 + (dk0 + 32) * 2) = pack8f(o2, 1.0f); }
}
constexpr int R3_SBS = 272;
DI void ret3_compute(const Args& a, LAS unsigned char* li, LAS unsigned char* sb, int b, int hd, int mc, int wi, int lane) {
    unsigned char* ws = a.ws; const bf16_t* P = (const bf16_t*)(ws + WS_P);
    const int row0 = chunk_row0(b, mc); const bool lat = mc < 128;
    const int h = lane >> 5, cl = lane & 31, iq = 32 * wi + cl;
    const float lgf = a.in[I_DECAY][hd] * 1.4426950408889634f, lgb = a.in[I_DECAY][4 + hd] * 1.4426950408889634f;
    bf16x8 Qf[8];
    {
        const bf16_t* src = P + (size_t)(row0 + iq) * 2560 + 512 + 128 * hd + 8 * h;
        u32x4 raw[8];
#pragma unroll
        for (int s = 0; s < 8; ++s) raw[s] = *(const u32x4*)(src + 16 * s);
        const int t = mc * 128 + iq;
#pragma unroll
        for (int grp = 0; grp < 2; ++grp)
#pragma unroll
            for (int s1 = 0; s1 < 2; ++s1) { const int s = 4 * grp + s1; const int pos = grp ? (t & 63) : (t >> 6);
                const f32x2* tab = lat ? (const f32x2*)(ws + WS_ROPE) + pos * 32 : nullptr;
                float o1[8], o2[8]; rope8(raw[s], raw[s + 2], tab, 16 * s1 + 8 * h, 1.0f, o1, o2);
                Qf[s] = __builtin_bit_cast(bf16x8, pack8f(o1, 1.0f)); Qf[s + 2] = __builtin_bit_cast(bf16x8, pack8f(o2, 1.0f)); }
    }
    f32x16 O[4];
    {
        const bf16_t* SinB = (const bf16_t*)(ws + WS_SIN) + ((((size_t)b * 4 + hd) * 2 + 0) * 130 + mc) * 16384;
        const float wqf = ex2(lgf * (float)(iq + 1)), wqb = ex2(lgb * (float)(128 - iq));
        const int lt = 64 * wi + lane, r0 = lt >> 4, ch = lt & 15;
        u32x4 nx0 = *(const u32x4*)(SinB + (size_t)r0 * 128 + 8 * ch), nx1 = *(const u32x4*)(SinB + (size_t)(r0 + 16) * 128 + 8 * ch);
#pragma unroll
        for (int g = 0; g < 8; ++g) {
            const int dir = g >> 2, dvt = g & 3;
            *(LAS u32x4*)(sb + r0 * R3_SBS + ch * 16) = nx0; *(LAS u32x4*)(sb + (r0 + 16) * R3_SBS + ch * 16) = nx1;
            if (g + 1 < 8) { const int dir1 = (g + 1) >> 2, dvt1 = (g + 1) & 3; const bf16_t* nb = SinB + (size_t)dir1 * 130 * 16384 + (size_t)(32 * dvt1) * 128;
                nx0 = *(const u32x4*)(nb + (size_t)r0 * 128 + 8 * ch); nx1 = *(const u32x4*)(nb + (size_t)(r0 + 16) * 128 + 8 * ch); }
            __syncthreads();
            f32x16 d = zero16();
#pragma unroll
            for (int s = 0; s < 8; ++s) { const bf16x8 af = *(const LAS bf16x8*)(sb + cl * R3_SBS + (16 * s + 8 * h) * 2); d = MFMA32(af, Qf[s], d); }
            if (dir == 0) O[dvt] = d * wqf; else O[dvt] += d * wqb;
            __syncthreads();
        }
    }
    const int i16 = lane & 15, q4 = i16 >> 2, p4 = i16 & 3, blk = (lane >> 4) & 1;
    const unsigned vbase = (unsigned)(size_t)(li + 32768);
#pragma unroll 1
    for (int jt = 0; jt < 4; ++jt) {
        f32x16 st = zero16();
#pragma unroll
        for (int s = 0; s < 8; ++s) { const bf16x8 kf = *(const LAS bf16x8*)(li + (32 * jt + cl) * 256 + (16 * s + 8 * h) * 2); st = MFMA32(kf, Qf[s], st); }
#pragma unroll
        for (int rr = 0; rr < 16; ++rr) { const int j = 32 * jt + crow(rr, h), d = iq - j;
            const float fd = (float)d; const float w = ex2(d > 0 ? lgf * fd : -lgb * fd) + (d == 0 ? 1.0f : 0.0f); st[rr] *= w; }
#pragma unroll
        for (int s2 = 0; s2 < 2; ++s2) {
            const bf16x8 pf = pack8(st, s2);
            const unsigned rlo = (unsigned)(32 * jt + 16 * s2 + 4 * h + q4) * 256u, rhi = rlo + 8u * 256u, cofs = (unsigned)(16 * blk + 4 * p4) * 2u;
            bf16x8 vf[4]; tr_read4<2048>(vbase + rlo + cofs, vf); (void)rhi;
#pragma unroll
            for (int dvt = 0; dvt < 4; ++dvt) O[dvt] = MFMA32(vf[dvt], pf, O[dvt]);
        }
        asm volatile("" ::: "memory");
    }
    float ss = 0.f;
#pragma unroll
    for (int dvt = 0; dvt < 4; ++dvt)
#pragma unroll
        for (int rr = 0; rr < 16; ++rr) ss += O[dvt][rr] * O[dvt][rr];
    ss += __shfl_xor(ss, 32);
    const float rstd = 1.0f / sqrtf(ss * (1.0f / 128.0f) + 1e-6f);
    const size_t r = (size_t)(row0 + iq);
    bf16_t* AR = (bf16_t*)(ws + WS_AR);
#pragma unroll
    for (int dvt = 0; dvt < 4; ++dvt)
#pragma unroll
        for (int g4 = 0; g4 < 4; ++g4) { const int dv = 32 * dvt + 8 * g4 + 4 * h;
            const u32x2 gw = *(const u32x2*)(P + r * 2560 + 2048 + 128 * hd + dv);
            float gv[4] = {bflo(gw[0]), bfhi(gw[0]), bflo(gw[1]), bfhi(gw[1])}, o[4];
#pragma unroll
            for (int e = 0; e < 4; ++e) o[e] = O[dvt][4 * g4 + e] * rstd * (gv[e] * sigmoidf_(gv[e]));
            u32x2 w; w[0] = pk2(o[0], o[1]); w[1] = pk2(o[2], o[3]);
            *(u32x2*)(AR + r * 1024 + 512 + 128 * hd + dv) = w; }
}

DI int scan_mc(int dr, int sc) { return dr == 0 ? (sc < 2 ? 128 + sc : sc - 2) : (sc < 2 ? 129 - sc : 129 - sc); }

DI void scan_pass1(const Args& a, LAS unsigned char* lds) {
    const int tid = threadIdx.x, lane = tid & 63, wave = tid >> 6;
    for (int it = (int)blockIdx.x - 16; it < 1040; it += (int)gridDim.x - 16) {
        if (it < 0) break;
        const int b = it / 520, q = it % 520, mc = q / 4, g = (q % 4) * 8 + wave; s5_item<false>(a, lds + wave * S5_WAVE_LDS, b, g, mc, lane); }
    __syncthreads();
    ret1_loop(a, lds);
}
DI void scan_pass2(const Args& a) {
    const int tid = threadIdx.x, lane = tid & 63, wave = tid >> 6; unsigned char* ws = a.ws;
    if (blockIdx.x < 128 && wave == 0) {
        const int ch = blockIdx.x, b = ch >> 6, dr = (ch >> 5) & 1, g = ch & 31;
        const f32x4 t = ((const f32x4*)(ws + WS_S5A))[(dr * 32 + g) * 64 + lane]; const float pr = t[2], pi = t[3];
        const f32x2* E = (const f32x2*)(ws + WS_S5E) + (((size_t)b * 2 + dr) * 32 + g) * 130 * 64 + lane; f32x2* Hn = (f32x2*)(ws + WS_S5H) + (((size_t)b * 2 + dr) * 32 + g) * 130 * 64 + lane;
        float hr = 0.f, hi = 0.f;
        for (int s0 = 0; s0 < 130; s0 += 10) {
            f32x2 e[10];
#pragma unroll
            for (int k = 0; k < 10; ++k) e[k] = E[(size_t)scan_mc(dr, s0 + k) * 64];
#pragma unroll
            for (int k = 0; k < 10; ++k) { Hn[(size_t)scan_mc(dr, s0 + k) * 64] = (f32x2){hr, hi}; const float nr = pr * hr - pi * hi + e[k][0], ni = pr * hi + pi * hr + e[k][1]; hr = nr; hi = ni; }
        }
    }
    const int gt = blockIdx.x * NTHR + tid;
    for (int id = gt; id < 16 * 8192; id += gridDim.x * NTHR) {
        const int chn = id >> 13, pe = id & 8191, dvp = pe >> 7, dk = pe & 127, dr = chn & 1, hd = (chn >> 1) & 3;
        const float g128 = __expf(a.in[I_DECAY][dr * 4 + hd] * 128.0f);
        const unsigned* KV = (const unsigned*)(ws + WS_KVL) + (size_t)chn * 130 * 8192 + pe; bf16_t* Sn = (bf16_t*)(ws + WS_SIN) + (size_t)chn * 130 * 16384 + (2 * dvp) * 128 + dk;
        float s0v = 0.f, s1v = 0.f;
        for (int c0 = 0; c0 < 130; c0 += 10) {
            unsigned kv[10];
#pragma unroll
            for (int k = 0; k < 10; ++k) kv[k] = KV[(size_t)scan_mc(dr, c0 + k) * 8192];
#pragma unroll
            for (int k = 0; k < 10; ++k) { const unsigned w = pk2(s0v, s1v); bf16_t* o = Sn + (size_t)scan_mc(dr, c0 + k) * 16384; o[0] = (bf16_t)(w & 0xffffu); o[128] = (bf16_t)(w >> 16);
                s0v = g128 * s0v + bflo(kv[k]); s1v = g128 * s1v + bfhi(kv[k]); }
        }
    }
}
DI void scan_pass3(const Args& a, LAS unsigned char* lds) {
    const int tid = threadIdx.x, lane = tid & 63, wave = tid >> 6;
    for (int it = (int)blockIdx.x - 8; it < 1040; it += (int)gridDim.x - 8) {
        if (it < 0) break;
        const int b = it / 520, q = it % 520, mc = q / 4, g = (q % 4) * 8 + wave; s5_item_old<true>(a, lds + wave * S5_WAVE_LDS, b, g, mc, lane); }
    for (int p = blockIdx.x; p < 520; p += gridDim.x) { const int q = 2 * p + (wave >> 2), b = q / 520, r = q % 520, hd = r / 130, mc = r % 130;
        LAS unsigned char* li = lds + (wave >> 2) * 65536;
        __syncthreads(); ret3_stage(a, li, b, hd, mc, tid & 255); __syncthreads(); ret3_compute(a, li, lds + 131072 + (wave >> 2) * (32 * R3_SBS), b, hd, mc, wave & 3, lane); }
    __syncthreads();
}

template <int STRIDE>
DI void tr_read8(unsigned base, bf16x8 (&f)[2][2]) {
    s16x4 r0, r1, r2, r3, r4, r5, r6, r7;
    asm volatile("ds_read_b64_tr_b16 %0, %8 offset:%9\n\tds_read_b64_tr_b16 %1, %8 offset:%10\n\tds_read_b64_tr_b16 %2, %8 offset:%11\n\tds_read_b64_tr_b16 %3, %8 offset:%12\n\t"
                 "ds_read_b64_tr_b16 %4, %8 offset:%13\n\tds_read_b64_tr_b16 %5, %8 offset:%14\n\tds_read_b64_tr_b16 %6, %8 offset:%15\n\tds_read_b64_tr_b16 %7, %8 offset:%16\n\ts_waitcnt lgkmcnt(0)"
                 : "=&v"(r0), "=&v"(r1), "=&v"(r2), "=&v"(r3), "=&v"(r4), "=&v"(r5), "=&v"(r6), "=&v"(r7)
                 : "v"(base), "i"(0), "i"(8 * STRIDE), "i"(64), "i"(8 * STRIDE + 64), "i"(16 * STRIDE), "i"(24 * STRIDE), "i"(16 * STRIDE + 64), "i"(24 * STRIDE + 64) : "memory");
    f[0][0] = __builtin_shufflevector(r0, r1, 0, 1, 2, 3, 4, 5, 6, 7); f[0][1] = __builtin_shufflevector(r2, r3, 0, 1, 2, 3, 4, 5, 6, 7);
    f[1][0] = __builtin_shufflevector(r4, r5, 0, 1, 2, 3, 4, 5, 6, 7); f[1][1] = __builtin_shufflevector(r6, r7, 0, 1, 2, 3, 4, 5, 6, 7);
}
constexpr int NA_ST = 144;
DI void na_phase(const Args& a, LAS unsigned char* lds) {
    int tid = threadIdx.x; asm volatile("" : "+v"(tid));
    const int lane = tid & 63, wave = tid >> 6; unsigned char* ws = a.ws;
    const bf16_t* QKV = (const bf16_t*)(ws + WS_P);
    bf16_t* AR = (bf16_t*)(ws + WS_AR);
    LAS unsigned char* cK = lds; LAS unsigned char* cV = lds + 256 * NA_ST;
    LAS unsigned char* vl = lds + 2 * 256 * NA_ST + wave * (32 * NA_ST);
    LAS float* rpbl = (LAS float*)(lds + 2 * 256 * NA_ST + 8 * 32 * NA_ST);
    LAS unsigned char* kl = lds + 114688 + wave * (32 * NA_ST);
    const int h = lane >> 5, cl = lane & 31, i16 = lane & 15, q4 = i16 >> 2, p4 = i16 & 3, blk = (lane >> 4) & 1;
    const float L2E = 1.4426950408889634f;
    const int c = blockIdx.x, b = c >> 7, hd = (c >> 3) & 15;
#pragma unroll
    for (int i = 0; i < 8; ++i) { const int ch = tid + 512 * i, which = ch >> 11, key = (ch >> 3) & 255, cc = ch & 7;
        const u32x4 v = *(const u32x4*)(QKV + (size_t)(NLAT + b * CTXL + key) * 3072 + (which ? 2048 : 1024) + 64 * hd + 8 * cc);
        *(LAS u32x4*)((which ? cV : cK) + key * NA_ST + cc * 16) = v; }
    for (int i = tid; i < 15 * 31; i += NTHR) rpbl[i] = a.in[I_RPB][hd * 465 + i] * L2E;
    __syncthreads();
    const unsigned vtr = (unsigned)(size_t)vl + (unsigned)((4 * h + q4) * NA_ST + (16 * blk + 4 * p4) * 2);
    const unsigned ctr = (unsigned)(size_t)cV + (unsigned)((4 * h + q4) * NA_ST + (16 * blk + 4 * p4) * 2);
#pragma unroll 1
    for (int j = 0; j < 8; ++j) {
        const int r = (c & 7) * 32 + 4 * j + (wave >> 1), qt = wave & 1;
        const int rs = min(max(r - 4, 0), 248), cb = qt ? 24 : 0;
        const int cq = 32 * qt + cl, cs = min(max(cq - 8, 0), 48);
        const size_t qrow = (size_t)b * SEQ + r * 64 + cq;
        bf16x8 Qf[4];
        {
            const size_t qrow0 = qrow - cl;
#pragma unroll
            for (int ii = 0; ii < 4; ++ii) { const int cc = lane + 64 * ii; const u32x4 qv = *(const u32x4*)(QKV + (qrow0 + (cc >> 3)) * 3072 + 64 * hd + 8 * (cc & 7)); *(LAS u32x4*)(kl + (cc >> 3) * NA_ST + (cc & 7) * 16) = qv; }
#pragma unroll
            for (int s = 0; s < 4; ++s) Qf[s] = *(const LAS bf16x8*)(kl + cl * NA_ST + (16 * s + 8 * h) * 2);
            LDS_WAIT();
        }
        float m_run = -1e30f, l_run = 0.f; f32x16 O[2] = {zero16(), zero16()};
        const bf16_t* kvb = QKV + ((size_t)b * SEQ + rs * 64 + cb) * 3072 + 64 * hd;
        const int koff0 = ((cl & 7) * 64 + (cl >> 3)) * 3072 + 1024 + 8 * h;
        int voff0[4];
#pragma unroll
        for (int ii = 0; ii < 4; ++ii) { const int cc = lane + 64 * ii, key = cc >> 3, ch = cc & 7; voff0[ii] = ((key & 7) * 64 + (key >> 3)) * 3072 + 2048 + 8 * ch; }
        int rowb[4];
#pragma unroll
        for (int q = 0; q < 4; ++q) rowb[q] = (rs + q + 4 * h - r + 7) * 31;
        u32x4 Kn[4], Vn[4];
#pragma unroll
        for (int ii = 0; ii < 4; ++ii) Kn[ii] = *(const u32x4*)(kvb + voff0[ii] - 1024);
#pragma unroll
        for (int ii = 0; ii < 4; ++ii) Vn[ii] = *(const u32x4*)(kvb + voff0[ii]);
#pragma unroll 1
        for (int kt = 0; kt < 10; ++kt) {
#pragma unroll
            for (int ii = 0; ii < 4; ++ii) { const int cc = lane + 64 * ii; *(LAS u32x4*)(kl + (cc >> 3) * NA_ST + (cc & 7) * 16) = Kn[ii]; *(LAS u32x4*)(vl + (cc >> 3) * NA_ST + (cc & 7) * 16) = Vn[ii]; }
            if (kt < 9) { const bf16_t* nb = kvb + (size_t)(kt + 1) * 4 * 3072;
#pragma unroll
                for (int ii = 0; ii < 4; ++ii) Kn[ii] = *(const u32x4*)(nb + voff0[ii] - 1024);
#pragma unroll
                for (int ii = 0; ii < 4; ++ii) Vn[ii] = *(const u32x4*)(nb + voff0[ii]); }
            f32x16 st = zero16();
#pragma unroll
            for (int s = 0; s < 4; ++s) { const bf16x8 kf = *(const LAS bf16x8*)(kl + cl * NA_ST + (16 * s + 8 * h) * 2); st = MFMA32(kf, Qf[s], st); }
            bf16x8 vf[2][2]; tr_read8<NA_ST>(vtr, vf);
            float mx = -1e30f;
            float bias[16];
#pragma unroll
            for (int g = 0; g < 4; ++g) { const int co = min(max(cb + 4 * kt + g - cq + 15, 0), 30);
#pragma unroll
                for (int q = 0; q < 4; ++q) bias[4 * g + q] = rpbl[rowb[q] + co]; }
#pragma unroll
            for (int rr = 0; rr < 16; ++rr) asm volatile("" : "+v"(bias[rr]));
#pragma unroll
            for (int g = 0; g < 4; ++g) {
                const int kcol = cb + 4 * kt + g; const bool valid = (kcol >= cs) && (kcol < cs + 16);
#pragma unroll
                for (int q = 0; q < 4; ++q) { const int rr = 4 * g + q;
                    const float sv = valid ? st[rr] * (0.125f * L2E) + bias[rr] : -INFINITY;
                    st[rr] = sv; mx = fmaxf(mx, sv); }
            }
            mx = fmaxf(mx, __shfl_xor(mx, 32));
            const float mnew = fmaxf(m_run, mx), alpha = ex2(m_run - mnew);
            float ls = 0.f;
#pragma unroll
            for (int rr = 0; rr < 16; ++rr) { const float pv = ex2(st[rr] - mnew); st[rr] = pv; ls += pv; }
            l_run = l_run * alpha + ls; m_run = mnew;
            if (!__all(alpha == 1.0f)) { O[0] *= alpha; O[1] *= alpha; }
#pragma unroll
            for (int s2 = 0; s2 < 2; ++s2) { const bf16x8 pf = pack8(st, s2); O[0] = MFMA32(vf[s2][0], pf, O[0]); O[1] = MFMA32(vf[s2][1], pf, O[1]); }
        }
#pragma unroll 1
        for (int kt = 0; kt < 8; ++kt) {
            f32x16 st = zero16();
#pragma unroll
            for (int s = 0; s < 4; ++s) { const bf16x8 kf = *(const LAS bf16x8*)(cK + (32 * kt + cl) * NA_ST + (16 * s + 8 * h) * 2); st = MFMA32(kf, Qf[s], st); }
            bf16x8 vf[2][2]; tr_read8<NA_ST>(ctr + (unsigned)(32 * kt * NA_ST), vf);
            float mx = -1e30f;
#pragma unroll
            for (int rr = 0; rr < 16; ++rr) mx = fmaxf(mx, st[rr]);
            mx = fmaxf(mx, __shfl_xor(mx, 32)) * (0.125f * L2E);
            const float mnew = fmaxf(m_run, mx), alpha = ex2(m_run - mnew);
            float ls = 0.f;
#pragma unroll
            for (int rr = 0; rr < 16; ++rr) { const float pv = ex2(st[rr] * (0.125f * L2E) - mnew); st[rr] = pv; ls += pv; }
            l_run = l_run * alpha + ls; m_run = mnew;
            if (!__all(alpha == 1.0f)) { O[0] *= alpha; O[1] *= alpha; }
#pragma unroll
            for (int s2 = 0; s2 < 2; ++s2) { const bf16x8 pf = pack8(st, s2); O[0] = MFMA32(vf[s2][0], pf, O[0]); O[1] = MFMA32(vf[s2][1], pf, O[1]); }
        }
        const float inv8 = 8.0f / (l_run + __shfl_xor(l_run, 32));
        u32x4 f0, f1;
#pragma unroll
        for (int g4 = 0; g4 < 4; ++g4) {
            const unsigned x = pk4_fp8(O[0][4 * g4] * inv8, O[0][4 * g4 + 1] * inv8, O[0][4 * g4 + 2] * inv8, O[0][4 * g4 + 3] * inv8);
            const unsigned y = pk4_fp8(O[1][4 * g4] * inv8, O[1][4 * g4 + 1] * inv8, O[1][4 * g4 + 2] * inv8, O[1][4 * g4 + 3] * inv8);
            auto r = __builtin_amdgcn_permlane32_swap(x, y, false, false);
            const unsigned a0 = r[0], a1 = r[1];
            if (g4 < 2) { f0[2 * g4] = a0; f0[2 * g4 + 1] = a1; } else { f1[2 * (g4 - 2)] = a0; f1[2 * (g4 - 2) + 1] = a1; }
        }
        { unsigned char* op = (unsigned char*)AR + qrow * 1024 + 64 * hd + 32 * h; *(u32x4*)op = f0; *(u32x4*)(op + 16) = f1; }
    }
    __syncthreads();
}

constexpr int NPH = 21;
__global__ void __launch_bounds__(NTHR, 2) mega(Args a) {
    extern __shared__ __attribute__((aligned(16))) unsigned char lds_raw[];
    LAS unsigned char* lds = (LAS unsigned char*)lds_raw;
    unsigned char* ws = a.ws;
    volatile LAS unsigned* ctlw = (volatile LAS unsigned*)(lds + LDS_CTL_OFF);
    if (threadIdx.x < 64) ctlw[threadIdx.x] = 0u;
    __syncthreads();
    const bool multi = (a.ph_hi - a.ph_lo) > 1;
    XcdBarrier bar; bar.bar = (unsigned*)(ws + WS_CTL); bar.x = 0; bar.st = ctlw;
    if (multi) bar = xcd_barrier_post((unsigned*)(ws + WS_CTL), ctlw);
    const int lo = a.ph_lo, hi = a.ph_hi;
#ifndef PH_MASK
#define PH_MASK 0x1fffff
#endif
#define IN(k) (((PH_MASK >> (k)) & 1) && lo <= (k) && (k) < hi)
#define SEAM(k) do { if (IN((k) + 1)) xcd_barrier(bar); } while (0)
#ifndef PROBE_DUP
#define PROBE_DUP 0
#endif
    const int G = gridDim.x, c = blockIdx.x;
    if (IN(0)) { p0_prologue(a, lds);
        if ((PROBE_DUP >> 0) & 1) { xcd_barrier(bar); { p0_prologue(a, lds); } }
        SEAM(0); }
    if (IN(1)) { row_phase<0>(a, lds, 0, NROW);
        if ((PROBE_DUP >> 1) & 1) { xcd_barrier(bar); { row_phase<0>(a, lds, 0, NROW); } }
        SEAM(1); }
    if (IN(2)) { pg8::DenseOrder S; S.init(NROW, 2560, 512, ws + WS_WIN, G, c); S.fill_rowtab((LAS int*)(lds + pg8::STAGE_BYTES)); pg8::EpiBf16 E{(bf16_t*)(ws + WS_P), 2560}; pg8::gemm_phase<true, true, 127, 121>(lds, ws + WS_H, 512, S, E); __syncthreads();
        if ((PROBE_DUP >> 2) & 1) { xcd_barrier(bar); { pg8::DenseOrder S; S.init(NROW, 2560, 1024, ws + WS_WIN, G, c); pg8::EpiBf16 E{(bf16_t*)(ws + WS_P), 2560}; pg8::gemm_phase<false, false, 127, 127>(lds, ws + WS_H, 1024, S, E); } }
        SEAM(2); }
    if (IN(3)) { scan_pass1(a, lds);
        if ((PROBE_DUP >> 3) & 1) { xcd_barrier(bar); { scan_pass1(a, lds); } }
        SEAM(3); }
    if (IN(4)) { scan_pass2(a);
        if ((PROBE_DUP >> 4) & 1) { xcd_barrier(bar); { scan_pass2(a); } }
        SEAM(4); }
    if (IN(5)) { scan_pass3(a, lds);
        if ((PROBE_DUP >> 5) & 1) { xcd_barrier(bar); { scan_pass3(a, lds); } }
        SEAM(5); }
    if (IN(6)) { pg8::DenseOrder S; S.init(NROW, 512, 512, ws + WS_WGLU, G, c); pg8::EpiGlu E{(const bf16_t*)(ws + WS_YG), (bf16_t*)(ws + WS_AR)}; pg8::gemm_phase<false, false, 127, 127>(lds, ws + WS_YG, 512, S, E);
        if ((PROBE_DUP >> 6) & 1) { xcd_barrier(bar); { pg8::DenseOrder S; S.init(NROW, 512, 512, ws + WS_WGLU, G, c); pg8::EpiGlu E{(const bf16_t*)(ws + WS_YG), (bf16_t*)(ws + WS_AR)}; pg8::gemm_phase<false, false, 127, 127>(lds, ws + WS_YG, 512, S, E); } }
        SEAM(6); }
    if (IN(7)) { pg8::DenseOrder S; S.init(NROW, 1024, 1024, ws + WS_WOUT, G, c);
        pg8::EpiResid<false> E{a.in[I_X], a.in[I_CTX], (bf16_t*)(ws + WS_XS), (const float*)(ws + WS_MODF) + 2 * 1024}; pg8::gemm_phase<false, false, 127, 127>(lds, ws + WS_AR, 1024, S, E);
        if ((PROBE_DUP >> 7) & 1) { xcd_barrier(bar); { pg8::DenseOrder S; S.init(NROW, 1024, 1024, ws + WS_WOUT, G, c);
        pg8::EpiResid<false> E{a.in[I_X], a.in[I_CTX], (bf16_t*)(ws + WS_XS), (const float*)(ws + WS_MODF) + 2 * 1024}; pg8::gemm_phase<false, false, 127, 127>(lds, ws + WS_AR, 1024, S, E); } }
        SEAM(7); }
    if (IN(8)) { router_phase(a, lds, 0, NROW);
        if ((PROBE_DUP >> 8) & 1) { xcd_barrier(bar); { router_phase(a, lds, 0, NROW); } }
        SEAM(8); }
    if (IN(9)) { slots_phase(a, lds, NROW);
        if ((PROBE_DUP >> 9) & 1) { xcd_barrier(bar); { slots_phase(a, lds, NROW); } }
        SEAM(9); }
    if (IN(10)) { moe_gemm<1>(a, lds, 0);
        if ((PROBE_DUP >> 10) & 1) { xcd_barrier(bar); { moe_gemm<1>(a, lds, 0); } }
        SEAM(10); }
#ifndef PROBE_G2
#define PROBE_G2 0
#endif
    if (IN(11)) { moe_gemm<2>(a, lds, 0);
        if (PROBE_G2) { xcd_barrier(bar); moe_gemm2_probe<PROBE_G2>(a, lds, 0); }
        if ((PROBE_DUP >> 11) & 1) { xcd_barrier(bar); { moe_gemm<2>(a, lds, 0); } }
        SEAM(11); }
    if (IN(12)) { row_phase<2>(a, lds, 0, NROW);
        if ((PROBE_DUP >> 12) & 1) { xcd_barrier(bar); { row_phase<2>(a, lds, 0, NROW); } }
        SEAM(12); }
    if (IN(13)) { pg8::DenseOrder S; S.init(NROW, 3072, 512, ws + WS_WQKV, G, c); S.fill_rowtab((LAS int*)(lds + pg8::STAGE_BYTES)); pg8::EpiBf16 E{(bf16_t*)(ws + WS_P), 3072}; pg8::gemm_phase<true, true, 127, 121>(lds, ws + WS_H, 512, S, E); __syncthreads();
        if ((PROBE_DUP >> 13) & 1) { xcd_barrier(bar); { pg8::DenseOrder S; S.init(NROW, 3072, 512, ws + WS_WQKV, G, c); S.fill_rowtab((LAS int*)(lds + pg8::STAGE_BYTES)); pg8::EpiBf16 E{(bf16_t*)(ws + WS_P), 3072}; pg8::gemm_phase<true, true, 127, 121>(lds, ws + WS_H, 512, S, E); __syncthreads(); } }
        SEAM(13); }
    if (IN(14)) { na_phase(a, lds);
        if ((PROBE_DUP >> 14) & 1) { xcd_barrier(bar); { na_phase(a, lds); } }
        SEAM(14); }
    if (IN(15)) { pg8::DenseOrder S; S.init(NLAT, 1024, 512, ws + WS_WO, G, c); S.fill_rowtab((LAS int*)(lds + pg8::STAGE_BYTES));
        pg8::EpiResid<true> E{nullptr, nullptr, (bf16_t*)(ws + WS_XS), (const float*)(ws + WS_MODF) + 3 * 6144 + 2 * 1024};
        pg8::gemm_phase<true, true, 124, 121>(lds, ws + WS_AR, 512, S, E); __syncthreads();
        if ((PROBE_DUP >> 15) & 1) { xcd_barrier(bar); { pg8::DenseOrder S; S.init(NLAT, 1024, 512, ws + WS_WO, G, c); S.fill_rowtab((LAS int*)(lds + pg8::STAGE_BYTES));
        pg8::EpiResid<true> E{nullptr, nullptr, (bf16_t*)(ws + WS_XS), (const float*)(ws + WS_MODF) + 3 * 6144 + 2 * 1024};
        pg8::gemm_phase<true, true, 124, 121>(lds, ws + WS_AR, 512, S, E); __syncthreads(); } }
        SEAM(15); }
    if (IN(16)) { router_phase(a, lds, 1, NLAT);
        if ((PROBE_DUP >> 16) & 1) { xcd_barrier(bar); { router_phase(a, lds, 1, NLAT); } }
        SEAM(16); }
    if (IN(17)) { slots_phase(a, lds, NLAT);
        if ((PROBE_DUP >> 17) & 1) { xcd_barrier(bar); { slots_phase(a, lds, NLAT); } }
        SEAM(17); }
    if (IN(18)) { moe_gemm<1>(a, lds, 1);
        if ((PROBE_DUP >> 18) & 1) { xcd_barrier(bar); { moe_gemm<1>(a, lds, 1); } }
        SEAM(18); }
    if (IN(19)) { moe_gemm<2>(a, lds, 1);
        if ((PROBE_DUP >> 19) & 1) { xcd_barrier(bar); { moe_gemm<2>(a, lds, 1); } }
        SEAM(19); }
    if (IN(20)) { row_phase<3>(a, lds, 1, NLAT);
        if ((PROBE_DUP >> 20) & 1) { xcd_barrier(bar); { row_phase<3>(a, lds, 1, NLAT); } }
        }
#undef IN
#undef SEAM
}

#ifndef MK_PER_PHASE
#define MK_PER_PHASE 0
#endif
extern "C" void kernel_launch(void* const* d_in, const int* in_sizes, int n_in, void* d_out, int out_size, void* d_ws, size_t ws_size, hipStream_t stream) {
    static int grid = 0;
    if (grid == 0) {
        if (n_in != N_IN || ws_size < WS_END) { fprintf(stderr, "kernel_launch: unexpected n_in %d or ws %zu < %zu\n", n_in, ws_size, (size_t)WS_END); grid = -1; return; }
        int dev = 0, cus = 0, per_cu = 0;
        if (hipGetDevice(&dev) != hipSuccess || hipDeviceGetAttribute(&cus, hipDeviceAttributeMultiprocessorCount, dev) != hipSuccess) { grid = -1; return; }
        if (hipFuncSetAttribute((const void*)mega, hipFuncAttributeMaxDynamicSharedMemorySize, LDS_BYTES) != hipSuccess) { fprintf(stderr, "kernel_launch: hipFuncSetAttribute failed\n"); grid = -1; return; }
        if (hipOccupancyMaxActiveBlocksPerMultiprocessor(&per_cu, (const void*)mega, NTHR, LDS_BYTES) != hipSuccess || per_cu < 1) fprintf(stderr, "kernel_launch: occupancy query says %d\n", per_cu);
        (void)hipGetLastError();
        grid = cus;
        if (grid != 256) { fprintf(stderr, "kernel_launch: expected 256 CUs, got %d\n", grid); grid = 256; }
    }
    if (grid < 0) return;
    (void)in_sizes; (void)out_size;
    (void)hipMemsetAsync((char*)d_ws + WS_CTL, 0, CTL_BYTES, stream);
    Args a{};
    for (int i = 0; i < N_IN; ++i) a.in[i] = (const float*)d_in[i];
    a.out = (float*)d_out; a.ws = (unsigned char*)d_ws;
#if MK_PER_PHASE
    for (int p = 0; p < NPH; ++p) { a.ph_lo = p; a.ph_hi = p + 1; hipLaunchKernelGGL(mega, dim3(grid), dim3(NTHR), LDS_BYTES, stream, a); }
#else
    a.ph_lo = 0; a.ph_hi = NPH; hipLaunchKernelGGL(mega, dim3(grid), dim3(NTHR), LDS_BYTES, stream, a);
#endif
}
```
